# Optimizing an MI355X kernel written in HIP

```python
import jax, jax.numpy as jnp
from jax import lax
import numpy as np

D_MODEL = 1024
BATCH = 8
SEQ = 4096
DEPTH = 2

N_EVEN = (DEPTH + 1) // 2
N_ODD = DEPTH // 2
NORM_EPS = 1e-6

RG_WIDTH = D_MODEL
RG_HEADS = 8
RG_HEAD_DIM = RG_WIDTH // RG_HEADS
RG_CONV = 4
RG_C = 8.0
RG_CONV_LEFT = 2
SC_WIDTH = D_MODEL
SC_CONV = 3
SC_CONV_LEFT = 1
EVEN_IN = 2 * RG_WIDTH + 4 * SC_WIDTH
EVEN_MIX = RG_WIDTH + SC_WIDTH
GLA_HEADS = 4
GLA_KEY = D_MODEL // 2
GLA_VAL = D_MODEL
GLA_DK = GLA_KEY // GLA_HEADS
GLA_DV = GLA_VAL // GLA_HEADS
GLA_RANK = 16
GLA_NORMALIZER = 16.0
GLA_CHUNK = 64
ODD_IN = 2 * GLA_KEY + 2 * GLA_VAL + 2 * GLA_RANK

kernel_name = 'hybrid_rglru_shortconv_gla_encoder'


def rmsnorm(x, g):
    xf = x.astype(jnp.float32)
    y = xf * lax.rsqrt(jnp.mean(xf * xf, axis=-1, keepdims=True) + NORM_EPS)
    return (y * g.astype(jnp.float32)).astype(x.dtype)


def centred_dwconv(u, w, left):
    seq = u.shape[1]
    width = w.shape[0]
    up = jnp.pad(u, ((0, 0), (left, width - 1 - left), (0, 0)))
    out = up[:, 0:seq] * w[0]
    for k in range(1, width):
        out = out + up[:, k:k + seq] * w[k]
    return out


def rg_lru(u, gate_w, gate_b, lam, reverse):
    bsz, seq, width = u.shape
    uf = u.astype(jnp.float32)
    uh = uf.reshape(bsz, seq, RG_HEADS, RG_HEAD_DIM)
    gates = jax.nn.sigmoid(
        jnp.einsum('bshi,ghij->gbshj', uh, gate_w.astype(jnp.float32))
        + gate_b[:, None, None].astype(jnp.float32))
    r = gates[0].reshape(bsz, seq, width)
    i = gates[1].reshape(bsz, seq, width)
    log_a = -RG_C * r * jax.nn.softplus(-lam.astype(jnp.float32))
    a = jnp.exp(log_a)
    b = jnp.sqrt(-jnp.expm1(2.0 * log_a)) * (i * uf)

    def combine(left, right):
        a_l, b_l = left
        a_r, b_r = right
        return (a_l * a_r, a_r * b_l + b_r)

    _, h = lax.associative_scan(combine, (a, b), reverse=reverse, axis=1)
    return h


def gla_chunked(q, k, v, g):
    bsz, nh, seq, dk = q.shape
    dv = v.shape[-1]
    nc = seq // GLA_CHUNK
    qc = q.astype(jnp.float32).reshape(bsz, nh, nc, GLA_CHUNK, dk) * (dk ** -0.5)
    kc = k.astype(jnp.float32).reshape(bsz, nh, nc, GLA_CHUNK, dk)
    vc = v.astype(jnp.float32).reshape(bsz, nh, nc, GLA_CHUNK, dv)
    gc = g.reshape(bsz, nh, nc, GLA_CHUNK, dk)
    bcum = jnp.cumsum(gc, axis=3)
    btot = bcum[..., -1:, :]
    q_in = qc * jnp.exp(bcum)
    k_in = kc * jnp.exp(-bcum)
    k_st = kc * jnp.exp(btot - bcum)
    mask = jnp.tril(jnp.ones((GLA_CHUNK, GLA_CHUNK), dtype=bool))
    scores = jnp.einsum('bhnid,bhnjd->bhnij', q_in, k_in)
    scores = jnp.where(mask, scores, 0.0)
    o_intra = jnp.einsum('bhnij,bhnje->bhnie', scores, vc)
    decay = jnp.exp(btot[..., 0, :])

    def step(state, xs):
        q_n, k_n, v_n, dec_n = xs
        o_n = jnp.einsum('bhcd,bhde->bhce', q_n, state)
        state = dec_n[..., None] * state + jnp.einsum('bhcd,bhce->bhde', k_n, v_n)
        return state, o_n

    xs = (jnp.moveaxis(q_in, 2, 0), jnp.moveaxis(k_st, 2, 0),
          jnp.moveaxis(vc, 2, 0), jnp.moveaxis(decay, 2, 0))
    state0 = jnp.zeros((bsz, nh, dk, dv), jnp.float32)
    _, o_inter = lax.scan(step, state0, xs)
    o_inter = jnp.moveaxis(o_inter, 0, 2)
    return (o_intra + o_inter).reshape(bsz, nh, seq, dv)


def even_layer(x, norm_pre, norm_post, w_in, conv_w, conv_b, gate_w, gate_b, lam, sc_w, w_out):
    h = rmsnorm(x, norm_pre)
    proj = h @ w_in
    xa, za, xb, gb, gc, zb = jnp.split(
        proj, [RG_WIDTH, 2 * RG_WIDTH, 2 * RG_WIDTH + SC_WIDTH,
               2 * RG_WIDTH + 2 * SC_WIDTH, 2 * RG_WIDTH + 3 * SC_WIDTH], axis=-1)
    ua = centred_dwconv(xa, conv_w, RG_CONV_LEFT) + conv_b
    ya = rg_lru(ua, gate_w[0], gate_b[0], lam[0], False) + rg_lru(ua, gate_w[1], gate_b[1], lam[1], True)
    ya = ya * jax.nn.silu(za.astype(jnp.float32))
    yb = gb * centred_dwconv(gc * xb, sc_w, SC_CONV_LEFT)
    yb = yb * jax.nn.silu(zb)
    y = jnp.concatenate([ya, yb.astype(jnp.float32)], axis=-1) @ w_out
    return (x + rmsnorm(y, norm_post)).astype(x.dtype)


def odd_layer(x, norm_pre, norm_post, w_in, w_gate_lr, b_gate, head_norm_g, w_out):
    bsz, seq, _ = x.shape
    h = rmsnorm(x, norm_pre)
    proj = h @ w_in
    q, k, v, r, lr = jnp.split(
        proj, [GLA_KEY, 2 * GLA_KEY, 2 * GLA_KEY + GLA_VAL, 2 * GLA_KEY + 2 * GLA_VAL], axis=-1)
    lr = lr.reshape(bsz, seq, 2, GLA_RANK).astype(jnp.float32)
    z = jnp.einsum('bsdr,drk->dbsk', lr, w_gate_lr.astype(jnp.float32)) + b_gate[:, None, None].astype(jnp.float32)
    log_alpha = jax.nn.log_sigmoid(z) / GLA_NORMALIZER

    def heads(t, dh):
        return jnp.transpose(t.reshape(bsz, seq, GLA_HEADS, dh), (0, 2, 1, 3))

    qh, kh, vh = heads(q, GLA_DK), heads(k, GLA_DK), heads(v, GLA_DV)
    g_f, g_b = heads(log_alpha[0], GLA_DK), heads(log_alpha[1], GLA_DK)
    o_f = gla_chunked(qh, kh, vh, g_f)
    o_b = jnp.flip(gla_chunked(jnp.flip(qh, 2), jnp.flip(kh, 2), jnp.flip(vh, 2), jnp.flip(g_b, 2)), 2)
    o = rmsnorm(o_f + o_b, head_norm_g)
    o = jnp.transpose(o, (0, 2, 1, 3)).reshape(bsz, seq, GLA_VAL)
    y = (o * jax.nn.silu(r.astype(jnp.float32))) @ w_out
    return (x + rmsnorm(y, norm_post)).astype(x.dtype)


def setup_inputs(seed: int = 0) -> dict:
    key = jax.random.key(seed)
    ks = jax.random.split(key, 20)
    nrm = jax.random.normal
    f32 = jnp.float32
    lam_a = jax.random.uniform(ks[8], (N_EVEN, 2, RG_WIDTH), f32, minval=0.9, maxval=0.999)
    lam_s = lam_a ** (1.0 / RG_C)
    rg_lambda = jnp.log(lam_s) - jnp.log1p(-lam_s)
    return {
        'x': nrm(ks[0], (BATCH, SEQ, D_MODEL), f32),
        'even_norm_pre': 1.0 + 0.05 * nrm(ks[1], (N_EVEN, D_MODEL), f32),
        'even_norm_post': 1.0 + 0.05 * nrm(ks[2], (N_EVEN, D_MODEL), f32),
        'even_w_in': nrm(ks[3], (N_EVEN, D_MODEL, EVEN_IN), f32) * D_MODEL ** -0.5,
        'rg_conv_w': nrm(ks[4], (N_EVEN, RG_CONV, RG_WIDTH), f32) * RG_CONV ** -0.5,
        'rg_conv_b': 0.01 * nrm(ks[5], (N_EVEN, RG_WIDTH), f32),
        'rg_gate_w': nrm(ks[6], (N_EVEN, 2, 2, RG_HEADS, RG_HEAD_DIM, RG_HEAD_DIM), f32) * RG_HEAD_DIM ** -0.5,
        'rg_gate_b': 0.01 * nrm(ks[7], (N_EVEN, 2, 2, RG_HEADS, RG_HEAD_DIM), f32),
        'rg_lambda': rg_lambda,
        'sc_conv_w': nrm(ks[9], (N_EVEN, SC_CONV, SC_WIDTH), f32) * SC_CONV ** -0.5,
        'even_w_out': nrm(ks[10], (N_EVEN, EVEN_MIX, D_MODEL), f32) * EVEN_MIX ** -0.5,
        'odd_norm_pre': 1.0 + 0.05 * nrm(ks[11], (N_ODD, D_MODEL), f32),
        'odd_norm_post': 1.0 + 0.05 * nrm(ks[12], (N_ODD, D_MODEL), f32),
        'odd_w_in': nrm(ks[13], (N_ODD, D_MODEL, ODD_IN), f32) * D_MODEL ** -0.5,
        'gla_w_gate_lr': nrm(ks[14], (N_ODD, 2, GLA_RANK, GLA_KEY), f32) * GLA_RANK ** -0.5,
        'gla_b_gate': 1.0 + 0.3 * nrm(ks[15], (N_ODD, 2, GLA_KEY), f32),
        'gla_norm_g': 1.0 + 0.05 * nrm(ks[16], (N_ODD, GLA_DV), f32),
        'odd_w_out': nrm(ks[17], (N_ODD, GLA_VAL, D_MODEL), f32) * GLA_VAL ** -0.5,
    }


def reference(x, even_norm_pre, even_norm_post, even_w_in, rg_conv_w, rg_conv_b, rg_gate_w,
              rg_gate_b, rg_lambda, sc_conv_w, even_w_out, odd_norm_pre, odd_norm_post,
              odd_w_in, gla_w_gate_lr, gla_b_gate, gla_norm_g, odd_w_out):
    for layer in range(DEPTH):
        j = layer // 2
        if layer % 2 == 0:
            x = even_layer(x, even_norm_pre[j], even_norm_post[j], even_w_in[j], rg_conv_w[j],
                           rg_conv_b[j], rg_gate_w[j], rg_gate_b[j], rg_lambda[j],
                           sc_conv_w[j], even_w_out[j])
        else:
            x = odd_layer(x, odd_norm_pre[j], odd_norm_post[j], odd_w_in[j], gla_w_gate_lr[j],
                          gla_b_gate[j], gla_norm_g[j], odd_w_out[j])
    return x
```

```cpp
#include <hip/hip_runtime.h>
#include <hip/hip_cooperative_groups.h>
#include <cstdio>
#include <cstdint>
namespace cg = cooperative_groups;

#ifndef MK_MULTI
#define MK_MULTI 0
#endif

#define LAS __attribute__((address_space(3)))
typedef unsigned short bf16;
typedef short bf16x8 __attribute__((ext_vector_type(8)));
typedef float f32x4 __attribute__((ext_vector_type(4)));
typedef float f32x2 __attribute__((ext_vector_type(2)));
typedef unsigned u32x4 __attribute__((ext_vector_type(4)));
typedef unsigned u32x2 __attribute__((ext_vector_type(2)));

namespace pg8 {
typedef unsigned short bf16_t;
constexpr int BM = 256, BK = 64, HALF = 128, HTB = HALF * BK * 2, STAGE_BYTES = 8 * HTB, NXCD = 8, WGM = 8;
__host__ __device__ __forceinline__ int lds_byte(int r, int c) { const int st = (r >> 4) * 2 + (c >> 5), rr = r & 15, cc = c & 31, ob = rr * 64 + cc * 2; return st * 1024 + (ob ^ (((ob >> 9) & 1) << 5)); }
__host__ __device__ __forceinline__ void stage_rc(int b, int& R, int& C) { const int st = b / 1024, sb = b % 1024, swz = sb ^ (((sb >> 9) & 1) << 5); R = (st >> 1) * 16 + swz / 64; C = (st & 1) * 32 + (swz % 64) / 2; }
__host__ __device__ __forceinline__ int perm32(int rho) { const int n = rho >> 4, i = rho & 15; return 8 * (i >> 2) + 4 * n + (i & 3); }
struct Unit { int pm, pn; };
struct Gemm { const bf16_t* A; const bf16_t* Bt; int M, N, K; };
struct StaticOrder {
    int nM, nN, nwg, G, c;
    __host__ __device__ void init(int M, int N, int G_, int c_) { nM = M / BM; nN = N / BM; nwg = nM * nN; G = G_; c = c_; }
    __host__ __device__ bool next(int i, Unit& u) const {
        const long L = (long)i * G + c; if (L >= nwg) return false;
        int wgid = (int)L; { const int q = nwg / NXCD, r = nwg % NXCD, xcd = wgid % NXCD, off = wgid / NXCD; wgid = (xcd < r ? xcd * (q + 1) : r * (q + 1) + (xcd - r) * q) + off; }
        const int nig = WGM * nN, gid = wgid / nig, fm = gid * WGM, gsz = (nM - fm) < WGM ? (nM - fm) : WGM;
        u.pm = fm + ((wgid % nig) % gsz); u.pn = (wgid % nig) / gsz; return true;
    }
    __device__ __forceinline__ void a_ready(const Unit&) const {}
    __device__ __forceinline__ void done(const Unit&) const {}
};
typedef float f32x2_t __attribute__((ext_vector_type(2))); typedef __bf16 bf16x2_t __attribute__((ext_vector_type(2)));
__device__ __forceinline__ unsigned cvt_pk_bf16(float lo, float hi) { f32x2_t v = {lo, hi}; bf16x2_t b = __builtin_convertvector(v, bf16x2_t); return __builtin_bit_cast(unsigned, b); }
struct EpiBf16 {
    static constexpr bool PERM = true, AFTER_DRAIN = false;
    bf16_t* O; int ldc; int sa_lo, sa_hi, sb_lo, sb_hi;
    static __device__ __forceinline__ f32x4 silu4(const f32x4 v) { f32x4 r;
#pragma unroll
        for (int i = 0; i < 4; ++i) r[i] = v[i] * __builtin_amdgcn_rcpf(1.f + __builtin_amdgcn_exp2f(-1.4426950408889634f * v[i]));
        return r; }
    __device__ __forceinline__ void operator()(const f32x4 (&acc)[2][2][4][2], const Unit& u, int wr, int wc, int fr, int fq) const {
        const int row0 = u.pm * BM + wr * 64 + fr; const int col0 = u.pn * BM + wc * 32 + 8 * fq;
        const bool act = (u.pn >= sa_lo && u.pn < sa_hi) || (u.pn >= sb_lo && u.pn < sb_hi);
#pragma unroll
        for (int ai = 0; ai < 2; ++ai)
#pragma unroll
            for (int m = 0; m < 4; ++m) { bf16_t* rowp = O + (size_t)(row0 + ai * HALF + m * 16) * ldc + col0;
#pragma unroll
                for (int bj = 0; bj < 2; ++bj) { f32x4 v0 = acc[ai][bj][m][0], v1 = acc[ai][bj][m][1];
                    if (act) { v0 = silu4(v0); v1 = silu4(v1); }
                    u32x4 w; w.x = cvt_pk_bf16(v0[0], v0[1]); w.y = cvt_pk_bf16(v0[2], v0[3]); w.z = cvt_pk_bf16(v1[0], v1[1]); w.w = cvt_pk_bf16(v1[2], v1[3]);
                    *(u32x4*)(rowp + bj * HALF) = w; } }
    }
};
template <class Epi, class Sched, bool ALIGN_EPI = false, bool SP2 = false>
__device__ __forceinline__ void gemm_phase(LAS unsigned char* lds, const Gemm g, const Sched& S, const Epi& E) {
    const int tid = threadIdx.x, wid = __builtin_amdgcn_readfirstlane(tid >> 6), lane = tid & 63, wr = wid >> 2, wc = wid & 3, fr = lane & 15, fq = lane >> 4;
    const int K = g.K, nt = K / BK;
    unsigned voffA[2], voffB[2];
#pragma unroll
    for (int i = 0; i < 2; ++i) { int R, C; stage_rc(tid * 16 + i * 8192, R, C); const int Rb = Epi::PERM ? ((R & ~31) + perm32(R & 31)) : R;
        voffA[i] = (unsigned)(R * K + C) * 2u; voffB[i] = (unsigned)(Rb * K + C) * 2u; }
    const size_t kstep = (size_t)(BK * 2);
    const size_t hstep = (size_t)HALF * K * 2;
    const size_t tstep = 2 * hstep;
    const unsigned ldsw = (unsigned)wid * 1024u;
    const int aoff = lds_byte(wr * 64 + fr, fq * 8), boff = lds_byte(wc * 32 + fr, fq * 8);
#define PG8_SA(b, h) (((b) * 2 + (h)) * HTB)
#define PG8_SB(b, h) ((4 + (b) * 2 + (h)) * HTB)
#define PG8_STAGE(bufoff, gbase, voff) do { _Pragma("unroll") for (int _i = 0; _i < 2; ++_i) \
        __builtin_amdgcn_global_load_lds((const unsigned*)((const char*)(gbase) + (voff)[_i]), (LAS unsigned*)(lds + (bufoff) + ldsw + _i * 8192), 16, 0, 0); } while (0)
#define PG8_LDA(dst, b, h) do { _Pragma("unroll") for (int m = 0; m < 4; ++m) _Pragma("unroll") for (int k = 0; k < 2; ++k) dst[m][k] = *(const LAS bf16x8*)(lds + PG8_SA(b, h) + aoff + m * 2048 + k * 1024); } while (0)
#define PG8_LDB(dst, b, h) do { _Pragma("unroll") for (int n = 0; n < 2; ++n) _Pragma("unroll") for (int k = 0; k < 2; ++k) dst[n][k] = *(const LAS bf16x8*)(lds + PG8_SB(b, h) + boff + n * 2048 + k * 1024); } while (0)
#define PG8_MMA(ai, bj, At, Bt) do { __builtin_amdgcn_s_setprio(1); _Pragma("unroll") for (int m = 0; m < 4; ++m) _Pragma("unroll") for (int n = 0; n < 2; ++n) _Pragma("unroll") for (int k = 0; k < 2; ++k) \
        acc[ai][bj][m][n] = __builtin_amdgcn_mfma_f32_16x16x32_bf16(Bt[n][k], At[m][k], acc[ai][bj][m][n], 0, 0, 0); __builtin_amdgcn_s_setprio(0); } while (0)
#define PG8_WAIT_V(n) asm volatile("s_waitcnt vmcnt(" #n ")" ::: "memory")
#define PG8_WAIT_L(n) asm volatile("s_waitcnt lgkmcnt(" #n ")" ::: "memory")
#define PG8_BAR __builtin_amdgcn_s_barrier()
#define PG8_SCHED __builtin_amdgcn_sched_barrier(0)
    Unit cur, nxt; int ui = 0;
    if (!S.next(0, cur)) return;
    f32x4 acc[2][2][4][2];
#pragma unroll
    for (int a = 0; a < 2; ++a)
#pragma unroll
        for (int b = 0; b < 2; ++b)
#pragma unroll
            for (int m = 0; m < 4; ++m)
#pragma unroll
                for (int n = 0; n < 2; ++n) acc[a][b][m][n] = (f32x4){0.f, 0.f, 0.f, 0.f};
    bf16x8 At[4][2], B0[2][2], B1[2][2];
    const char* cA = (const char*)g.A + (size_t)cur.pm * tstep; const char* cB = (const char*)g.Bt + (size_t)cur.pn * tstep;
    S.a_ready(cur);
    if constexpr (SP2) {
        PG8_STAGE(PG8_SB(0, 0), cB, voffB); PG8_STAGE(PG8_SB(0, 1), cB + hstep, voffB); PG8_STAGE(PG8_SA(0, 0), cA, voffA); PG8_STAGE(PG8_SA(0, 1), cA + hstep, voffA);
        if (wr == 1) PG8_BAR;
        PG8_WAIT_V(2); PG8_BAR;
        PG8_STAGE(PG8_SB(1, 0), cB + kstep, voffB); PG8_STAGE(PG8_SA(1, 0), cA + kstep, voffA); PG8_STAGE(PG8_SB(1, 1), cB + hstep + kstep, voffB);
        PG8_WAIT_V(6); PG8_BAR;
    } else {
        PG8_STAGE(PG8_SB(0, 0), cB, voffB); PG8_STAGE(PG8_SA(0, 0), cA, voffA); PG8_STAGE(PG8_SB(0, 1), cB + hstep, voffB); PG8_STAGE(PG8_SA(0, 1), cA + hstep, voffA);
        if (wr == 1) PG8_BAR;
        PG8_WAIT_V(4); PG8_BAR;
        PG8_STAGE(PG8_SB(1, 0), cB + kstep, voffB); PG8_STAGE(PG8_SA(1, 0), cA + kstep, voffA); PG8_STAGE(PG8_SB(1, 1), cB + hstep + kstep, voffB);
        PG8_WAIT_V(6); PG8_BAR;
    }
    for (;;) {
        const bool has_next = S.next(ui + 1, nxt);
        const char* nA = has_next ? (const char*)g.A + (size_t)nxt.pm * tstep : cA; const char* nB = has_next ? (const char*)g.Bt + (size_t)nxt.pn * tstep : cB;
        for (int t = 0; t < nt; t += 2) {
            const bool last = (t == nt - 2);
            const char* a1 = cA + (size_t)(t + 1) * kstep;
            const char* a2 = last ? nA : cA + (size_t)(t + 2) * kstep; const char* b2 = last ? nB : cB + (size_t)(t + 2) * kstep;
            const char* a3 = a2 + kstep; const char* b3 = b2 + kstep;
            if (last && has_next) S.a_ready(nxt);
            if constexpr (SP2) {
            PG8_LDB(B0, 0, 0); PG8_LDB(B1, 0, 1); PG8_SCHED; PG8_LDA(At, 0, 0); PG8_STAGE(PG8_SA(1, 1), a1 + hstep, voffA);
            PG8_WAIT_V(8); PG8_WAIT_L(0); PG8_BAR; PG8_MMA(0, 0, At, B0); PG8_MMA(0, 1, At, B1); PG8_BAR; PG8_SCHED;
            PG8_LDA(At, 0, 1); PG8_STAGE(PG8_SB(0, 0), b2, voffB); PG8_STAGE(PG8_SB(0, 1), b2 + hstep, voffB); PG8_STAGE(PG8_SA(0, 0), a2, voffA);
            PG8_WAIT_V(8); PG8_WAIT_L(0); PG8_BAR; PG8_MMA(1, 0, At, B0); PG8_MMA(1, 1, At, B1); PG8_BAR; PG8_SCHED;
            PG8_LDB(B0, 1, 0); PG8_LDB(B1, 1, 1); PG8_SCHED; PG8_LDA(At, 1, 0); PG8_STAGE(PG8_SA(0, 1), a2 + hstep, voffA);
            PG8_WAIT_V(8); PG8_WAIT_L(0); PG8_BAR; PG8_MMA(0, 0, At, B0); PG8_MMA(0, 1, At, B1); PG8_BAR; PG8_SCHED;
            PG8_LDA(At, 1, 1); PG8_STAGE(PG8_SB(1, 0), b3, voffB); PG8_STAGE(PG8_SB(1, 1), b3 + hstep, voffB); PG8_STAGE(PG8_SA(1, 0), a3, voffA);
            PG8_WAIT_V(8); PG8_WAIT_L(0); PG8_BAR; PG8_MMA(1, 0, At, B0); PG8_MMA(1, 1, At, B1); PG8_BAR; PG8_SCHED;
            } else {
            PG8_LDB(B0, 0, 0); PG8_SCHED; PG8_LDA(At, 0, 0); PG8_STAGE(PG8_SA(1, 1), a1 + hstep, voffA);
            PG8_WAIT_L(8); PG8_BAR; PG8_WAIT_L(0); PG8_MMA(0, 0, At, B0); PG8_BAR; PG8_SCHED;
            PG8_LDB(B1, 0, 1); PG8_STAGE(PG8_SB(0, 0), b2, voffB);
            PG8_BAR; PG8_WAIT_L(0); PG8_MMA(0, 1, At, B1); PG8_BAR;
            PG8_LDA(At, 0, 1); PG8_STAGE(PG8_SA(0, 0), a2, voffA);
            PG8_BAR; PG8_WAIT_L(0); PG8_MMA(1, 0, At, B0); PG8_BAR; PG8_SCHED;
            PG8_STAGE(PG8_SB(0, 1), b2 + hstep, voffB);
            PG8_WAIT_V(6); PG8_BAR; PG8_MMA(1, 1, At, B1); PG8_BAR;
            PG8_LDB(B0, 1, 0); PG8_SCHED; PG8_LDA(At, 1, 0); PG8_STAGE(PG8_SA(0, 1), a2 + hstep, voffA);
            PG8_WAIT_L(8); PG8_BAR; PG8_WAIT_L(0); PG8_MMA(0, 0, At, B0); PG8_BAR; PG8_SCHED;
            PG8_LDB(B1, 1, 1); PG8_STAGE(PG8_SB(1, 0), b3, voffB);
            PG8_BAR; PG8_WAIT_L(0); PG8_MMA(0, 1, At, B1); PG8_BAR;
            PG8_LDA(At, 1, 1); PG8_STAGE(PG8_SA(1, 0), a3, voffA);
            PG8_BAR; PG8_WAIT_L(0); PG8_MMA(1, 0, At, B0); PG8_BAR; PG8_SCHED;
            PG8_STAGE(PG8_SB(1, 1), b3 + hstep, voffB);
            PG8_WAIT_V(6); PG8_BAR; PG8_MMA(1, 1, At, B1); PG8_BAR;
            }
        }
        if constexpr (ALIGN_EPI) { if (wr == 0) PG8_BAR; }
        if constexpr (!Epi::AFTER_DRAIN) { E(acc, cur, wr, wc, fr, fq); S.done(cur); }
        if (!has_next) break;
#pragma unroll
        for (int a = 0; a < 2; ++a)
#pragma unroll
            for (int b = 0; b < 2; ++b)
#pragma unroll
                for (int m = 0; m < 4; ++m)
#pragma unroll
                    for (int n = 0; n < 2; ++n) acc[a][b][m][n] = (f32x4){0.f, 0.f, 0.f, 0.f};
        cur = nxt; cA = nA; cB = nB; ++ui;
        if constexpr (ALIGN_EPI) { if (wr == 1) PG8_BAR; }
    }
    PG8_WAIT_V(0);
    if constexpr (!ALIGN_EPI) { if (wr == 0) PG8_BAR; }
    PG8_BAR;
#undef PG8_SA
#undef PG8_SB
#undef PG8_STAGE
#undef PG8_LDA
#undef PG8_LDB
#undef PG8_MMA
#undef PG8_WAIT_V
#undef PG8_WAIT_L
#undef PG8_BAR
#undef PG8_SCHED
}
}

constexpr int NB = 8, SEQ = 4096, D = 1024, T = NB * SEQ;
constexpr int EVEN_IN = 6144, ODD_IN = 3104, ODD_PAD = 3328;
constexpr int CH = 64, NCH = SEQ / CH;
constexpr float EPS = 1e-6f;
constexpr int NT = 512, NWAVES = 8;
constexpr int LDS_BYTES = 147456;

constexpr size_t MiB = 1u << 20;
constexpr size_t WS_W1 = 0;
constexpr size_t WS_W2 = 12 * MiB;
constexpr size_t WS_W3 = 16 * MiB;
constexpr size_t WS_W4 = 23 * MiB;
constexpr size_t WS_GW = 25 * MiB;
constexpr size_t WS_SUMF = 26 * MiB;
constexpr size_t WS_SUMB = 30 * MiB;
constexpr size_t WS_CTL = 36 * MiB;
constexpr size_t WS_LR = 37 * MiB;
constexpr size_t WS_PROJ = 40 * MiB;
constexpr size_t WS_IMG1B = 248 * MiB;
constexpr size_t WS_OB2 = 354 * MiB;
constexpr size_t WS_H1 = 376 * MiB;
constexpr size_t WS_M1 = 248 * MiB;
constexpr size_t WS_Y2 = 312 * MiB;
constexpr size_t WS_Y = 440 * MiB;
constexpr size_t WS_END = 504 * MiB;

__device__ __forceinline__ unsigned pk2(float lo, float hi) { return pg8::cvt_pk_bf16(lo, hi); }
__device__ __forceinline__ float bflo(unsigned u) { return __uint_as_float(u << 16); }
__device__ __forceinline__ float bfhi(unsigned u) { return __uint_as_float(u & 0xffff0000u); }
__device__ __forceinline__ float wave_sum(float v) {
#pragma unroll
    for (int o = 1; o < 64; o <<= 1) v += __shfl_xor(v, o);
    return v;
}
__device__ __forceinline__ float sigmoidf_(float x) { return __builtin_amdgcn_rcpf(1.f + __expf(-x)); }
__device__ __forceinline__ float siluf_(float x) { return x * sigmoidf_(x); }
#define LDS_WAIT() asm volatile("s_waitcnt lgkmcnt(0)" ::: "memory")

__device__ __forceinline__ void p0_transpose_item(const float* W, int K, int N, bf16* WT, LAS float* scr, int item, int lane, float scale = 1.f) {
    const int nblk = N / 32, kb = item / nblk, nb = item % nblk, k0 = 64 * kb, n0 = 32 * nb;
#pragma unroll 8
    for (int i = 0; i < 32; ++i) { const int kk = 2 * i + (lane >> 5); scr[kk * 33 + (lane & 31)] = W[(size_t)(k0 + kk) * N + n0 + (lane & 31)] * scale; }
    LDS_WAIT(); asm volatile("" ::: "memory");
    const int c = lane & 7;
#pragma unroll
    for (int j = 0; j < 4; ++j) { const int n = (lane >> 3) + 8 * j; const LAS float* s = scr + (8 * c) * 33 + n;
        u32x4 o; o.x = pk2(s[0 * 33], s[1 * 33]); o.y = pk2(s[2 * 33], s[3 * 33]); o.z = pk2(s[4 * 33], s[5 * 33]); o.w = pk2(s[6 * 33], s[7 * 33]);
        *(u32x4*)(WT + (size_t)(n0 + n) * K + k0 + 8 * c) = o; }
    LDS_WAIT(); asm volatile("" ::: "memory");
}

__device__ __forceinline__ void row_load(const float* row, int lane, f32x4 (&v)[4]) {
    const f32x4* p = (const f32x4*)row + lane;
#pragma unroll
    for (int j = 0; j < 4; ++j) v[j] = p[64 * j];
}
__device__ __forceinline__ void row_load_bf16(const bf16* row, int lane, f32x4 (&v)[4]) {
    const u32x2* p = (const u32x2*)row + lane;
#pragma unroll
    for (int j = 0; j < 4; ++j) { const u32x2 w = p[64 * j]; v[j] = (f32x4){bflo(w.x), bfhi(w.x), bflo(w.y), bfhi(w.y)}; }
}
__device__ __forceinline__ float row_sumsq(const f32x4 (&v)[4]) {
    float s = 0.f;
#pragma unroll
    for (int j = 0; j < 4; ++j) s += (v[j].x * v[j].x + v[j].y * v[j].y) + (v[j].z * v[j].z + v[j].w * v[j].w);
    return wave_sum(s);
}
__device__ __forceinline__ void row_store_bf16(bf16* row, int lane, const f32x4 (&v)[4]) {
    u32x2* p = (u32x2*)row + lane;
#pragma unroll
    for (int j = 0; j < 4; ++j) { u32x2 w; w.x = pk2(v[j].x, v[j].y); w.y = pk2(v[j].z, v[j].w); p[64 * j] = w; }
}

struct Args {
    const float* x; const float* e_npre; const float* e_npost; const float* e_win; const float* rg_cw; const float* rg_cb; const float* rg_gw; const float* rg_gb;
    const float* rg_lam; const float* sc_w; const float* e_wout; const float* o_npre; const float* o_npost; const float* o_win; const float* g_wlr; const float* g_bg;
    const float* g_ng; const float* o_wout; float* out; unsigned char* ws; int ph_lo, ph_hi;
};

__device__ __forceinline__ void p0_prologue(LAS unsigned char* lds, const Args& a, int G) {
    const int tid = threadIdx.x, lane = tid & 63, wave = tid >> 6;
    LAS float* scr = (LAS float*)(lds + wave * 16384);
    const int gw = blockIdx.x * NWAVES + wave, NGW = G * NWAVES;
    constexpr int I1 = (D / 64) * (EVEN_IN / 32), I2 = (2048 / 64) * (D / 32), I3 = (D / 64) * (ODD_IN / 32), I4 = (D / 64) * (D / 32), I5 = 32 * 8;
    constexpr int NITEMS = I1 + I2 + I3 + I4 + I5;
    bf16* W1 = (bf16*)(a.ws + WS_W1); bf16* W2 = (bf16*)(a.ws + WS_W2); bf16* W3 = (bf16*)(a.ws + WS_W3); bf16* W4 = (bf16*)(a.ws + WS_W4); bf16* GW = (bf16*)(a.ws + WS_GW);
    for (int it = gw; it < NITEMS; it += NGW) {
        int r = it;
        if (r < I1) { p0_transpose_item(a.e_win, D, EVEN_IN, W1, scr, r, lane); continue; } r -= I1;
        if (r < I2) { p0_transpose_item(a.e_wout, 2048, D, W2, scr, r, lane); continue; } r -= I2;
        if (r < I3) { p0_transpose_item(a.o_win, D, ODD_IN, W3, scr, r, lane); continue; } r -= I3;
        if (r < I4) { p0_transpose_item(a.o_wout, D, D, W4, scr, r, lane); continue; } r -= I4;
        { const int m = r >> 3; p0_transpose_item(a.rg_gw + (size_t)m * 16384, 128, 128, GW + (size_t)m * 16384, scr, r & 7, lane, -1.4426950408889634f); }
    }
    { u32x4* z = (u32x4*)(W3 + (size_t)ODD_IN * D); const int n16 = (ODD_PAD - ODD_IN) * D * 2 / 16;
      for (int i = blockIdx.x * NT + tid; i < n16; i += G * NT) z[i] = (u32x4){0u, 0u, 0u, 0u}; }
    bf16* H0 = (bf16*)a.out;
    f32x4 gg[4]; row_load(a.e_npre, lane, gg);
    for (int m = gw; m < T; m += NGW) {
        f32x4 v[4]; row_load(a.x + (size_t)m * D, lane, v);
        const float rs = rsqrtf(row_sumsq(v) * (1.f / D) + EPS);
#pragma unroll
        for (int j = 0; j < 4; ++j) v[j] = v[j] * rs * gg[j];
        row_store_bf16(H0 + (size_t)m * D, lane, v);
    }
}

constexpr int EM_UB = 0, EM_CF = 51200, EM_CB = 59392;
template <int CTRL> __device__ __forceinline__ float dpp_f(float oldv, float src) {
    return __int_as_float(__builtin_amdgcn_update_dpp(__float_as_int(oldv), __float_as_int(src), CTRL, 0xf, 0xf, false));
}
template <bool BWD> __device__ __forceinline__ void row_scan(float& a, float& b) {
    if (!BWD) {
        { const float a2 = dpp_f<0x111>(1.f, a), b2 = dpp_f<0x111>(0.f, b); b = a * b2 + b; a = a * a2; }
        { const float a2 = dpp_f<0x112>(1.f, a), b2 = dpp_f<0x112>(0.f, b); b = a * b2 + b; a = a * a2; }
        { const float a2 = dpp_f<0x114>(1.f, a), b2 = dpp_f<0x114>(0.f, b); b = a * b2 + b; a = a * a2; }
        { const float a2 = dpp_f<0x118>(1.f, a), b2 = dpp_f<0x118>(0.f, b); b = a * b2 + b; a = a * a2; }
    } else {
        { const float a2 = dpp_f<0x101>(1.f, a), b2 = dpp_f<0x101>(0.f, b); b = a * b2 + b; a = a * a2; }
        { const float a2 = dpp_f<0x102>(1.f, a), b2 = dpp_f<0x102>(0.f, b); b = a * b2 + b; a = a * a2; }
        { const float a2 = dpp_f<0x104>(1.f, a), b2 = dpp_f<0x104>(0.f, b); b = a * b2 + b; a = a * a2; }
        { const float a2 = dpp_f<0x108>(1.f, a), b2 = dpp_f<0x108>(0.f, b); b = a * b2 + b; a = a * a2; }
    }
}

#define RAW_BAR() do { asm volatile("s_waitcnt lgkmcnt(0)" ::: "memory"); __builtin_amdgcn_s_barrier(); asm volatile("" ::: "memory"); } while (0)
constexpr int EM_BUF = 17408;
constexpr int EM_CF2 = 2 * EM_BUF, EM_CB2 = EM_CF2 + 8192, EM_CW = EM_CB2 + 8192, EM_GB = EM_CW + 2560, EM_SP = EM_GB + 2048, EM_GW0 = EM_SP + 1024;
struct EmRaw { u32x4 v[4][2]; };
__device__ __forceinline__ void em_load(EmRaw& R, const bf16* proj, int b, int head, int n, int tid) {
    const int t = tid >> 3, cgp = tid & 7, tseq = n * CH + t, chs = head * 128 + cgp * 16;
#pragma unroll
    for (int k = 0; k < 4; ++k) { int ts = tseq + k - 2; ts = ts < 0 ? 0 : (ts >= SEQ ? SEQ - 1 : ts);
        const bf16* row = proj + ((size_t)b * SEQ + ts) * EVEN_IN + chs;
        R.v[k][0] = *(const u32x4*)row; R.v[k][1] = *(const u32x4*)(row + 8); }
}
__device__ __forceinline__ void em_conv(LAS unsigned char* buf, const LAS float* CW, const EmRaw& R, int n, int tid) {
    const int t = tid >> 3, cgp = tid & 7, tseq = n * CH + t;
    float u[16];
#pragma unroll
    for (int e4 = 0; e4 < 4; ++e4) { const f32x4 bb = *(const LAS f32x4*)(CW + 4 * 128 + cgp * 16 + 4 * e4); u[4 * e4] = bb.x; u[4 * e4 + 1] = bb.y; u[4 * e4 + 2] = bb.z; u[4 * e4 + 3] = bb.w; }
#pragma unroll
    for (int k = 0; k < 4; ++k) { const int ts = tseq + k - 2; const float m = (ts >= 0 && ts < SEQ) ? 1.f : 0.f;
        const u32x4 v0 = R.v[k][0], v1 = R.v[k][1];
        const LAS float* wk = CW + k * 128 + cgp * 16;
        f32x4 w0 = *(const LAS f32x4*)wk, w1 = *(const LAS f32x4*)(wk + 4), w2 = *(const LAS f32x4*)(wk + 8), w3 = *(const LAS f32x4*)(wk + 12);
        w0 = w0 * m; w1 = w1 * m; w2 = w2 * m; w3 = w3 * m;
        u[0] += w0.x * bflo(v0.x); u[1] += w0.y * bfhi(v0.x); u[2] += w0.z * bflo(v0.y); u[3] += w0.w * bfhi(v0.y);
        u[4] += w1.x * bflo(v0.z); u[5] += w1.y * bfhi(v0.z); u[6] += w1.z * bflo(v0.w); u[7] += w1.w * bfhi(v0.w);
        u[8] += w2.x * bflo(v1.x); u[9] += w2.y * bfhi(v1.x); u[10] += w2.z * bflo(v1.y); u[11] += w2.w * bfhi(v1.y);
        u[12] += w3.x * bflo(v1.z); u[13] += w3.y * bfhi(v1.z); u[14] += w3.z * bflo(v1.w); u[15] += w3.w * bfhi(v1.w);
    }
    const int rho = (t & 3) | (((t >> 4) & 3) << 2) | (((t >> 2) & 3) << 4);
    LAS u32x4* ub = (LAS u32x4*)((LAS bf16*)(buf + EM_UB) + rho * 136 + cgp * 16);
    ub[0] = (u32x4){pk2(u[0], u[1]), pk2(u[2], u[3]), pk2(u[4], u[5]), pk2(u[6], u[7])};
    ub[1] = (u32x4){pk2(u[8], u[9]), pk2(u[10], u[11]), pk2(u[12], u[13]), pk2(u[14], u[15])};
}

struct BbRaw { u32x4 xb[3], gc[3], gb, zb; };
__device__ __forceinline__ void bb_load(BbRaw& B, const bf16* proj, int m, int chb) {
    const int tseq = m & (SEQ - 1);
#pragma unroll
    for (int k = 0; k < 3; ++k) { int ts = tseq + k - 1; ts = ts < 0 ? 0 : (ts >= SEQ ? SEQ - 1 : ts);
        const bf16* row = proj + (size_t)(m - tseq + ts) * EVEN_IN + chb;
        B.xb[k] = *(const u32x4*)(row + 2048); B.gc[k] = *(const u32x4*)(row + 4096); }
    const bf16* row = proj + (size_t)m * EVEN_IN + chb;
    B.gb = *(const u32x4*)(row + 3072); B.zb = *(const u32x4*)(row + 5120);
}
__device__ __forceinline__ void bb_compute(const BbRaw& B, const f32x4 (&wsc)[3][2], bf16* mix, int m, int chb, bool ok = true) {
    const int tseq = m & (SEQ - 1);
    float cv[8];
#pragma unroll
    for (int e = 0; e < 8; ++e) cv[e] = 0.f;
#pragma unroll
    for (int k = 0; k < 3; ++k) { const int ts = tseq + k - 1; const float msk = (ts >= 0 && ts < SEQ) ? 1.f : 0.f;
        const u32x4 xb = B.xb[k], gc = B.gc[k];
        const f32x4 w0 = wsc[k][0] * msk, w1 = wsc[k][1] * msk;
        cv[0] += w0.x * bflo(xb.x) * bflo(gc.x); cv[1] += w0.y * bfhi(xb.x) * bfhi(gc.x); cv[2] += w0.z * bflo(xb.y) * bflo(gc.y); cv[3] += w0.w * bfhi(xb.y) * bfhi(gc.y);
        cv[4] += w1.x * bflo(xb.z) * bflo(gc.z); cv[5] += w1.y * bfhi(xb.z) * bfhi(gc.z); cv[6] += w1.z * bflo(xb.w) * bflo(gc.w); cv[7] += w1.w * bfhi(xb.w) * bfhi(gc.w);
    }
    const u32x4 gb = B.gb, zb = B.zb;
    u32x4 o;
    o.x = pk2(bflo(gb.x) * cv[0] * bflo(zb.x), bfhi(gb.x) * cv[1] * bfhi(zb.x));
    o.y = pk2(bflo(gb.y) * cv[2] * bflo(zb.y), bfhi(gb.y) * cv[3] * bfhi(zb.y));
    o.z = pk2(bflo(gb.z) * cv[4] * bflo(zb.z), bfhi(gb.z) * cv[5] * bfhi(zb.z));
    o.w = pk2(bflo(gb.w) * cv[6] * bflo(zb.w), bfhi(gb.w) * cv[7] * bfhi(zb.w));
    if (ok) *(u32x4*)(mix + (size_t)m * 2048 + 1024 + chb) = o;
}

template <int PASS>
__device__ __forceinline__ void even_mixer(LAS unsigned char* lds, const Args& a, int G) {
    const int tid = threadIdx.x, lane = tid & 63, w = __builtin_amdgcn_readfirstlane(tid >> 6), q = lane >> 4, c = lane & 15;
    const bf16* proj = (const bf16*)(a.ws + WS_PROJ);
    bf16* mix = (bf16*)a.out;
    f32x2* sumF = (f32x2*)(a.ws + WS_SUMF); f32x2* sumB = (f32x2*)(a.ws + WS_SUMB);
    const bf16* gwt = (const bf16*)(a.ws + WS_GW);
    LAS float* CF = (LAS float*)(lds + EM_CF2); LAS float* CB = (LAS float*)(lds + EM_CB2); LAS float* CW = (LAS float*)(lds + EM_CW);
    const int gtid = blockIdx.x * NT + tid, chb = (gtid & 127) * 8, mstride = (G * NT) >> 7;
    int mb = gtid >> 7;
    f32x4 wsc[3][2];
    if (PASS == 0) {
#pragma unroll
        for (int k = 0; k < 3; ++k) { wsc[k][0] = *(const f32x4*)(a.sc_w + k * 1024 + chb); wsc[k][1] = *(const f32x4*)(a.sc_w + k * 1024 + chb + 4); }
    }
    for (int seg = blockIdx.x; seg < 256; seg += G) {
        const int head = seg & 7, b = (seg >> 3) & 7, n0 = (seg >> 6) * 16;
        const int j0 = 16 * w + 4 * q;
        const int ch0 = head * 128 + j0;
        __syncthreads();
        for (int i = tid; i < 5 * 128; i += NT) { const int k = i >> 7, j = i & 127; CW[i] = (k < 4) ? a.rg_cw[k * 1024 + head * 128 + j] : a.rg_cb[head * 128 + j]; }
        for (int i = tid; i < 4096; i += NT) { const int cb = i >> 11, j = (i >> 4) & 127, ch16 = i & 15;
            *(LAS u32x4*)(lds + EM_GW0 + (cb * 128 + j) * 272 + ch16 * 16) = *(const u32x4*)(gwt + (size_t)(cb * 8 + head) * 16384 + j * 128 + ch16 * 8); }
        { LAS float* GBs = (LAS float*)(lds + EM_GB); LAS float* SPs = (LAS float*)(lds + EM_SP);
          { const int cb = tid >> 7, j = tid & 127; GBs[tid] = -1.4426950408889634f * a.rg_gb[(cb * 8 + head) * 128 + j]; }
          if (tid < 256) { const int d = tid >> 7, j = tid & 127; SPs[tid] = -8.f * 1.4426950408889634f * log1pf(expf(-a.rg_lam[d * 1024 + head * 128 + j])); } }
        if (PASS == 1) {
            if (tid < 256) {
                const int dir = tid >> 7, j = tid & 127, ch = head * 128 + j;
                float h = 0.f;
                if (dir == 0) {
                    for (int m = 0; m < n0 + 16; ++m) { if (m >= n0) CF[(m - n0) * 128 + j] = h; const f32x2 s = sumF[((size_t)(b * NCH + m)) * 1024 + ch]; h = s.x * h + s.y; }
                } else {
                    for (int m = NCH - 1; m >= n0; --m) { if (m < n0 + 16) CB[(m - n0) * 128 + j] = h; const f32x2 s = sumB[((size_t)(b * NCH + m)) * 1024 + ch]; h = s.x * h + s.y; }
                }
            }
        }
        EmRaw R, Rn;
        em_load(R, proj, b, head, n0, tid);
        __syncthreads();
        em_conv(lds, CW, R, n0, tid);
        em_load(R, proj, b, head, n0 + 1, tid);
        RAW_BAR();
        for (int ci = 0; ci < 16; ++ci) {
            const int n = n0 + ci; const size_t tok0 = (size_t)b * SEQ + (size_t)n * CH;
            LAS unsigned char* buf = lds + (ci & 1) * EM_BUF;
            const LAS bf16* UB = (const LAS bf16*)(buf + EM_UB);
            int aoff = (head * 128 + 16 * w + c) * 128 + 8 * q;
            asm volatile("" : "+v"(aoff));
            bf16x8 Af1[2][4];
            BbRaw Bq;
            if (PASS == 0) bb_load(Bq, proj, mb < T ? mb : T - 1, chb);
            unsigned short zav[4][4];
            if (PASS == 1) {
#pragma unroll
                for (int tt = 0; tt < 4; ++tt)
#pragma unroll
                    for (int r = 0; r < 4; ++r) zav[tt][r] = *(const unsigned short*)(proj + (tok0 + 16 * q + 4 * tt + r) * EVEN_IN + 1024 + head * 128 + 16 * w + c);
            }
            { const int n2 = (ci + 2 < 16) ? n + 2 : n0 + 15; em_load(Rn, proj, b, head, n2, tid); }
            em_conv(lds + ((ci + 1) & 1) * EM_BUF, CW, R, n + 1, tid);
            const int chl = 16 * w + c;
            f32x4 z[4][4];
#pragma unroll
            for (int d = 0; d < 2; ++d) {
                const float gbr = ((const LAS float*)(lds + EM_GB))[(2 * d) * 128 + chl], gbi = ((const LAS float*)(lds + EM_GB))[(2 * d + 1) * 128 + chl];
                const float sp = ((const LAS float*)(lds + EM_SP))[d * 128 + chl];
#pragma unroll
                for (int tt = 0; tt < 4; ++tt) { z[2 * d][tt] = (f32x4){gbr, gbr, gbr, gbr}; z[2 * d + 1][tt] = (f32x4){gbi, gbi, gbi, gbi}; }
#pragma unroll
                for (int ks = 0; ks < 4; ++ks) {
                    bf16x8 Wf[2];
#pragma unroll
                    for (int g2 = 0; g2 < 2; ++g2) Wf[g2] = d ? Af1[g2][ks] : *(const LAS bf16x8*)(lds + EM_GW0 + (g2 * 128 + 16 * w + c) * 272 + (32 * ks + 8 * q) * 2);
#pragma unroll
                    for (int tt = 0; tt < 4; ++tt) { const bf16x8 At = *(const LAS bf16x8*)(UB + (16 * tt + c) * 136 + 32 * ks + 8 * q);
#pragma unroll
                        for (int g2 = 0; g2 < 2; ++g2) z[2 * d + g2][tt] = __builtin_amdgcn_mfma_f32_16x16x32_bf16(At, Wf[g2], z[2 * d + g2][tt], 0, 0, 0); } }
                if (d == 0) {
                    int aoff2 = aoff; asm volatile("" : "+v"(aoff2) : "v"(z[0][3][3]), "v"(z[1][3][3]));
#pragma unroll
                    for (int g2 = 0; g2 < 2; ++g2)
#pragma unroll
                        for (int ks = 0; ks < 4; ++ks) Af1[g2][ks] = *(const bf16x8*)(gwt + (size_t)((2 + g2) * 8) * 16384 + aoff2 + 32 * ks);
                }
#pragma unroll
                for (int tt = 0; tt < 4; ++tt)
#pragma unroll
                    for (int r = 0; r < 4; ++r) {
                        const float uu = __uint_as_float((unsigned)UB[(16 * tt + 4 * q + r) * 136 + chl] << 16);
                        const float rg = __builtin_amdgcn_rcpf(1.f + __builtin_amdgcn_exp2f(z[2 * d][tt][r])), ig = __builtin_amdgcn_rcpf(1.f + __builtin_amdgcn_exp2f(z[2 * d + 1][tt][r]));
                        const float av = __builtin_amdgcn_exp2f(sp * rg);
                        z[2 * d][tt][r] = av; z[2 * d + 1][tt][r] = __builtin_amdgcn_sqrtf(fmaxf(1.f - av * av, 0.f)) * ig * uu;
                    }
            }
            if (PASS == 0) { if (mb < T) bb_compute(Bq, wsc, mix, mb, chb); mb += mstride; bb_load(Bq, proj, mb < T ? mb : T - 1, chb); }
            const int ch = head * 128 + chl;
            if (PASS == 0) {
                float A = 1.f, H = 0.f;
#pragma unroll
                for (int tt = 0; tt < 4; ++tt)
#pragma unroll
                    for (int r = 0; r < 4; ++r) { H = z[0][tt][r] * H + z[1][tt][r]; A *= z[0][tt][r]; }
                const float A1 = __shfl(A, c + 16), A2 = __shfl(A, c + 32), A3 = __shfl(A, c + 48), A0 = __shfl(A, c);
                const float H0 = __shfl(H, c), H1 = __shfl(H, c + 16), H2 = __shfl(H, c + 32), H3 = __shfl(H, c + 48);
                const float PF = (A0 * A1) * (A2 * A3), HF = ((H0 * A1 + H1) * A2 + H2) * A3 + H3;
                A = 1.f; H = 0.f;
#pragma unroll
                for (int tt = 3; tt >= 0; --tt)
#pragma unroll
                    for (int r = 3; r >= 0; --r) { H = z[2][tt][r] * H + z[3][tt][r]; A *= z[2][tt][r]; }
                const float B0 = __shfl(A, c), B1 = __shfl(A, c + 16), B2 = __shfl(A, c + 32), B3 = __shfl(A, c + 48);
                const float G0 = __shfl(H, c), G1 = __shfl(H, c + 16), G2 = __shfl(H, c + 32), G3 = __shfl(H, c + 48);
                const float PB = (B0 * B1) * (B2 * B3), HB = ((G3 * B2 + G2) * B1 + G1) * B0 + G0;
                if (q == 0) { sumF[((size_t)(b * NCH + n)) * 1024 + ch] = (f32x2){PF, HF}; sumB[((size_t)(b * NCH + n)) * 1024 + ch] = (f32x2){PB, HB}; }
            } else {
                const float cfv = CF[ci * 128 + chl], cbv = CB[ci * 128 + chl];
                {
                    float A = 1.f, H = 0.f;
#pragma unroll
                    for (int tt = 0; tt < 4; ++tt)
#pragma unroll
                        for (int r = 0; r < 4; ++r) { H = z[0][tt][r] * H + z[1][tt][r]; A *= z[0][tt][r]; z[1][tt][r] = H; z[0][tt][r] = A; }
                    const float A0 = __shfl(A, c), A1 = __shfl(A, c + 16), A2 = __shfl(A, c + 32);
                    const float H0 = __shfl(H, c), H1 = __shfl(H, c + 16), H2 = __shfl(H, c + 32);
                    const float c1 = A0 * cfv + H0, c2 = A1 * c1 + H1, c3 = A2 * c2 + H2;
                    const float cin = q == 0 ? cfv : (q == 1 ? c1 : (q == 2 ? c2 : c3));
#pragma unroll
                    for (int tt = 0; tt < 4; ++tt)
#pragma unroll
                        for (int r = 0; r < 4; ++r) z[1][tt][r] = z[0][tt][r] * cin + z[1][tt][r];
                }
                {
                    float A = 1.f, H = 0.f;
#pragma unroll
                    for (int tt = 3; tt >= 0; --tt)
#pragma unroll
                        for (int r = 3; r >= 0; --r) { H = z[2][tt][r] * H + z[3][tt][r]; A *= z[2][tt][r]; z[3][tt][r] = H; z[2][tt][r] = A; }
                    const float A1 = __shfl(A, c + 16), A2 = __shfl(A, c + 32), A3 = __shfl(A, c + 48);
                    const float H1 = __shfl(H, c + 16), H2 = __shfl(H, c + 32), H3 = __shfl(H, c + 48);
                    const float d2 = A3 * cbv + H3, d1 = A2 * d2 + H2, d0 = A1 * d1 + H1;
                    const float cin = q == 3 ? cbv : (q == 2 ? d2 : (q == 1 ? d1 : d0));
#pragma unroll
                    for (int tt = 0; tt < 4; ++tt)
#pragma unroll
                        for (int r = 0; r < 4; ++r) z[1][tt][r] += z[2][tt][r] * cin + z[3][tt][r];
                }
#pragma unroll
                for (int tt = 0; tt < 4; ++tt)
#pragma unroll
                    for (int r = 0; r < 4; ++r) { const size_t tok = tok0 + 16 * q + 4 * tt + r;
                        const float o = z[1][tt][r] * __uint_as_float((unsigned)zav[tt][r] << 16);
                        *(unsigned short*)(mix + tok * 2048 + ch) = (unsigned short)(pk2(o, 0.f) & 0xffffu); }
            }
            if (PASS == 0) { if (mb < T) bb_compute(Bq, wsc, mix, mb, chb); mb += mstride; }
            R = Rn;
            RAW_BAR();
        }
    }
    if (PASS == 0) {
        for (; mb < T; mb += mstride) { BbRaw Bq; bb_load(Bq, proj, mb, chb); bb_compute(Bq, wsc, mix, mb, chb); }
    }
}

__device__ __forceinline__ void p5_rows(LAS unsigned char* lds, const Args& a, int G) {
    const int tid = threadIdx.x, lane = tid & 63, w = __builtin_amdgcn_readfirstlane(tid >> 6), q = lane >> 4, c = lane & 15;
    const bf16* Y = (const bf16*)(a.ws + WS_Y); bf16* H1 = (bf16*)(a.ws + WS_H1); bf16* LR = (bf16*)(a.ws + WS_LR);
    const bf16* WlrT = (const bf16*)(a.ws + WS_W3) + (size_t)3072 * D;
    LAS bf16* HL = (LAS bf16*)lds;
    LAS float* PL = (LAS float*)(lds + 66560);
    f32x4 g1[4], g2[4]; row_load(a.e_npost, lane, g1); row_load(a.o_npre, lane, g2);
    bf16x8 Bf[2][4];
#pragma unroll
    for (int nt = 0; nt < 2; ++nt)
#pragma unroll
        for (int ks = 0; ks < 4; ++ks) Bf[nt][ks] = *(const bf16x8*)(WlrT + (size_t)(16 * nt + c) * D + 128 * w + 32 * ks + 8 * q);
    for (int rg = blockIdx.x; rg < T / 32; rg += G) {
#pragma unroll
        for (int i = 0; i < 4; ++i) { const int rl = 4 * w + i; const size_t m = (size_t)rg * 32 + rl;
            f32x4 y[4], xv[4]; row_load_bf16(Y + m * D, lane, y); row_load(a.x + m * D, lane, xv);
            const float rs = rsqrtf(row_sumsq(y) * (1.f / D) + EPS);
#pragma unroll
            for (int j = 0; j < 4; ++j) xv[j] = xv[j] + y[j] * rs * g1[j];
            row_store_bf16((bf16*)(a.ws + WS_Y) + m * D, lane, xv);
            const float rs2 = rsqrtf(row_sumsq(xv) * (1.f / D) + EPS);
            u32x2* o = (u32x2*)(H1 + m * D) + lane;
#pragma unroll
            for (int j = 0; j < 4; ++j) { const f32x4 hv = xv[j] * rs2 * g2[j]; u32x2 pw; pw.x = pk2(hv.x, hv.y); pw.y = pk2(hv.z, hv.w);
                o[64 * j] = pw; *(LAS u32x2*)(HL + rl * 1032 + 4 * lane + 256 * j) = pw; }
        }
        RAW_BAR();
        f32x4 d[2][2];
#pragma unroll
        for (int mt = 0; mt < 2; ++mt) { d[mt][0] = (f32x4){0.f, 0.f, 0.f, 0.f}; d[mt][1] = (f32x4){0.f, 0.f, 0.f, 0.f}; }
#pragma unroll
        for (int ks = 0; ks < 4; ++ks)
#pragma unroll
            for (int mt = 0; mt < 2; ++mt) { const bf16x8 Af = *(const LAS bf16x8*)(HL + (16 * mt + c) * 1032 + 128 * w + 32 * ks + 8 * q);
                d[mt][0] = __builtin_amdgcn_mfma_f32_16x16x32_bf16(Af, Bf[0][ks], d[mt][0], 0, 0, 0); d[mt][1] = __builtin_amdgcn_mfma_f32_16x16x32_bf16(Af, Bf[1][ks], d[mt][1], 0, 0, 0); }
#pragma unroll
        for (int mt = 0; mt < 2; ++mt)
#pragma unroll
            for (int r = 0; r < 4; ++r) { PL[(w * 32 + 16 * mt + 4 * q + r) * 32 + c] = d[mt][0][r]; PL[(w * 32 + 16 * mt + 4 * q + r) * 32 + 16 + c] = d[mt][1][r]; }
        RAW_BAR();
#pragma unroll
        for (int i = 0; i < 2; ++i) { const int row = (tid >> 5) + 16 * i, n = tid & 31; float sacc = 0.f;
#pragma unroll
          for (int ww = 0; ww < 8; ++ww) sacc += PL[(ww * 32 + row) * 32 + n];
          LR[((size_t)rg * 32 + row) * 32 + n] = (bf16)(pk2(sacc, 0.f) & 0xffffu); }
    }
}
__device__ __forceinline__ void p8_rows(const Args& a, int G) {
    const int tid = threadIdx.x, lane = tid & 63, wave = tid >> 6, gw = blockIdx.x * NWAVES + wave, NGW = G * NWAVES;
    const bf16* proj = (const bf16*)(a.ws + WS_PROJ);
    bf16* M1 = (bf16*)(a.ws + WS_M1);
    const f32x4 gn = *((const f32x4*)a.g_ng + lane);
    for (int m = gw; m < T; m += NGW) {
        f32x4 of[4], ob[4], rr[4]; row_load_bf16(proj + (size_t)m * ODD_PAD, lane, of); row_load_bf16((const bf16*)(a.ws + WS_OB2) + (size_t)m * D, lane, ob);
        row_load_bf16(proj + (size_t)m * ODD_PAD + 2048, lane, rr);
#pragma unroll
        for (int j = 0; j < 4; ++j) { f32x4 o = of[j] + ob[j];
            const float ss = wave_sum((o.x * o.x + o.y * o.y) + (o.z * o.z + o.w * o.w));
            const float rs = rsqrtf(ss * (1.f / 256.f) + EPS);
            o = o * rs * gn;
            of[j] = (f32x4){o.x * siluf_(rr[j].x), o.y * siluf_(rr[j].y), o.z * siluf_(rr[j].z), o.w * siluf_(rr[j].w)}; }
        row_store_bf16(M1 + (size_t)m * D, lane, of);
    }
}
__device__ __forceinline__ void p10_rows(const Args& a, int G) {
    const int tid = threadIdx.x, lane = tid & 63, wave = tid >> 6, gw = blockIdx.x * NWAVES + wave, NGW = G * NWAVES;
    const bf16* X1 = (const bf16*)(a.ws + WS_Y); const bf16* Y2 = (const bf16*)(a.ws + WS_Y2);
    f32x4 g2[4]; row_load(a.o_npost, lane, g2);
    for (int m = gw; m < T; m += NGW) {
        f32x4 y2[4], xv[4]; row_load_bf16(X1 + (size_t)m * D, lane, xv); row_load_bf16(Y2 + (size_t)m * D, lane, y2);
        const float rs2 = rsqrtf(row_sumsq(y2) * (1.f / D) + EPS);
        f32x4* o = (f32x4*)(a.out + (size_t)m * D) + lane;
#pragma unroll
        for (int j = 0; j < 4; ++j) o[64 * j] = xv[j] + y2[j] * rs2 * g2[j];
    }
}

constexpr int GL_QI = 0, GL_KI = 17408, GL_DEC = 34816, GL_IMG = 35840, GL_VT = 35840, GL_BUF = 44032;
constexpr int GL_NI1 = GL_IMG / 1024, GL_NIV = 8;
typedef short v4i16_t __attribute__((ext_vector_type(4)));
__device__ __forceinline__ bf16x8 ld_tr8(const LAS unsigned char* img, int RS, int r0, int c0, int lane) {
    const int g = lane >> 4, qq = (lane & 15) >> 2, pp = lane & 3;
    const LAS unsigned char* p0 = img + (r0 + 8 * g + qq) * RS + 2 * c0 + 8 * pp;
    const v4i16_t lo = __builtin_amdgcn_ds_read_tr16_b64_v4i16((LAS v4i16_t*)p0), hi = __builtin_amdgcn_ds_read_tr16_b64_v4i16((LAS v4i16_t*)(p0 + 4 * RS));
    return __builtin_shufflevector(lo, hi, 0, 1, 2, 3, 4, 5, 6, 7);
}
__device__ __forceinline__ bf16x8 ld_tr8g(const LAS unsigned char* img, int RS, int rlo, int rhi, int c0, int lane) {
    const int qq = (lane & 15) >> 2, pp = lane & 3;
    const v4i16_t lo = __builtin_amdgcn_ds_read_tr16_b64_v4i16((LAS v4i16_t*)(img + (rlo + qq) * RS + 2 * c0 + 8 * pp)), hi = __builtin_amdgcn_ds_read_tr16_b64_v4i16((LAS v4i16_t*)(img + (rhi + qq) * RS + 2 * c0 + 8 * pp));
    return __builtin_shufflevector(lo, hi, 0, 1, 2, 3, 4, 5, 6, 7);
}
__device__ __forceinline__ bf16x8 pack8(const f32x4& lo, const f32x4& hi) {
    u32x4 p; p.x = pk2(lo[0], lo[1]); p.y = pk2(lo[2], lo[3]); p.z = pk2(hi[0], hi[1]); p.w = pk2(hi[2], hi[3]);
    return __builtin_bit_cast(bf16x8, p);
}
__device__ __forceinline__ bf16x8 ld2x8(const LAS bf16* p0, const LAS bf16* p1) {
    const u32x2 a = *(const LAS u32x2*)p0, b = *(const LAS u32x2*)p1; u32x4 r; r.x = a.x; r.y = a.y; r.z = b.x; r.w = b.y; return __builtin_bit_cast(bf16x8, r);
}
struct GlaRaw { bf16x8 Bz[2][4]; u32x2 qv[4], kv[4]; };
__device__ __forceinline__ void gla_load(GlaRaw& R, const bf16* proj, const bf16* lrp, int b, int h, int n, int w, int q, int c) {
    const size_t tok0 = (size_t)b * SEQ + (size_t)n * CH;
    const int kk0 = 16 * w + 4 * q;
#pragma unroll
    for (int tt = 0; tt < 4; ++tt) {
        const bf16* row = proj + (tok0 + 16 * tt + c) * ODD_PAD;
        const bf16* lr = lrp + (tok0 + 16 * tt + c) * 32 + 8 * (q & 1);
        R.Bz[0][tt] = *(const bf16x8*)lr; R.Bz[1][tt] = *(const bf16x8*)(lr + 16);
        R.qv[tt] = *(const u32x2*)(row + h * 128 + kk0); R.kv[tt] = *(const u32x2*)(row + 512 + h * 128 + kk0);
    }
}
__device__ __forceinline__ unsigned char* gla_img1(const Args& a, int b, int h, int dir, int n) {
    unsigned char* base = dir ? (a.ws + WS_IMG1B) : (unsigned char*)a.out;
    return base + ((size_t)((b * 4 + h) * NCH + n)) * GL_IMG;
}

__device__ __forceinline__ void gla_stage2(unsigned char* img0, unsigned char* img1, const GlaRaw& R, const bf16x8 (&Az)[2], const f32x4 (&bz)[2], int w, int q, int c) {
    const int kk0 = 16 * w + 4 * q;
    f32x4 g[2][4];
#pragma unroll
    for (int d = 0; d < 2; ++d)
#pragma unroll
        for (int tt = 0; tt < 4; ++tt) {
            const bf16x8 Bz = (q < 2) ? R.Bz[d][tt] : (bf16x8){0, 0, 0, 0, 0, 0, 0, 0};
            const f32x4 zz = __builtin_amdgcn_mfma_f32_16x16x32_bf16(Az[d], Bz, (f32x4){0.f, 0.f, 0.f, 0.f}, 0, 0, 0);
#pragma unroll
            for (int r = 0; r < 4; ++r) { const float xx = zz[r] + bz[d][r];
                g[d][tt][r] = (fminf(xx, 0.f) * 1.4426950408889634f - __builtin_amdgcn_logf(1.f + __builtin_amdgcn_exp2f(-1.4426950408889634f * fabsf(xx)))) * (1.f / 16.f); }
        }
    f32x4 P[2][4], rt[2][4];
#pragma unroll
    for (int d = 0; d < 2; ++d)
#pragma unroll
        for (int tt = 0; tt < 4; ++tt)
#pragma unroll
            for (int r = 0; r < 4; ++r) { float v = g[d][tt][r];
                v += dpp_f<0x111>(0.f, v); v += dpp_f<0x112>(0.f, v); v += dpp_f<0x114>(0.f, v); v += dpp_f<0x118>(0.f, v);
                P[d][tt][r] = v; }
#pragma unroll
    for (int d = 0; d < 2; ++d)
#pragma unroll
        for (int tt = 0; tt < 4; ++tt)
#pragma unroll
            for (int r = 0; r < 4; ++r) rt[d][tt][r] = __shfl(P[d][tt][r], 15, 16);
    f32x4 tot[2];
#pragma unroll
    for (int d = 0; d < 2; ++d) { f32x4 run = (f32x4){0.f, 0.f, 0.f, 0.f};
#pragma unroll
        for (int tt = 0; tt < 4; ++tt) { P[d][tt] = P[d][tt] + run; run = run + rt[d][tt]; }
        tot[d] = run; }
#pragma unroll
    for (int tt = 0; tt < 4; ++tt) { const int t = 16 * tt + c;
        const u32x2 qv = R.qv[tt], kv = R.kv[tt];
        const float qf[4] = {bflo(qv.x), bfhi(qv.x), bflo(qv.y), bfhi(qv.y)}, kf[4] = {bflo(kv.x), bfhi(kv.x), bflo(kv.y), bfhi(kv.y)};
#pragma unroll
        for (int d = 0; d < 2; ++d) { unsigned char* buf = d ? img1 : img0;
            float qi[4], ki[4];
#pragma unroll
            for (int r = 0; r < 4; ++r) { const float bc = d ? (tot[1][r] - P[1][tt][r] + g[1][tt][r]) : P[0][tt][r];
                qi[r] = qf[r] * 0.08838834764831845f * __builtin_amdgcn_exp2f(bc); ki[r] = kf[r] * __builtin_amdgcn_exp2f(-bc); }
            u32x2 o; o.x = pk2(qi[0], qi[1]); o.y = pk2(qi[2], qi[3]); *(u32x2*)((bf16*)(buf + GL_QI) + t * 136 + kk0) = o;
            o.x = pk2(ki[0], ki[1]); o.y = pk2(ki[2], ki[3]); *(u32x2*)((bf16*)(buf + GL_KI) + t * 136 + kk0) = o; }
    }
    if (c == 0) {
#pragma unroll
        for (int d = 0; d < 2; ++d) *(f32x4*)((float*)((d ? img1 : img0) + GL_DEC) + kk0) = (f32x4){__builtin_amdgcn_exp2f(tot[d][0]), __builtin_amdgcn_exp2f(tot[d][1]), __builtin_amdgcn_exp2f(tot[d][2]), __builtin_amdgcn_exp2f(tot[d][3])};
    }
}
__device__ __forceinline__ void gla_prep(LAS unsigned char* lds, const Args& a, int G) {
    const int tid = threadIdx.x, lane = tid & 63, w = __builtin_amdgcn_readfirstlane(tid >> 6), q = lane >> 4, c = lane & 15;
    const bf16* proj = (const bf16*)(a.ws + WS_PROJ);
    const bf16* lrp = (const bf16*)(a.ws + WS_LR);
    constexpr int NU = NB * 4 * NCH;
    int u = blockIdx.x;
    if (u >= NU) return;
    GlaRaw R, Rn;
    bf16x8 Az[2]; f32x4 bz[2];
#define GLA_GATE_W(AZ, BZ, h_) do { _Pragma("unroll") for (int d_ = 0; d_ < 2; ++d_) { float wv[8]; \
        _Pragma("unroll") for (int jj = 0; jj < 8; ++jj) wv[jj] = (q < 2) ? a.g_wlr[(size_t)(d_ * 16 + 8 * q + jj) * 512 + (h_) * 128 + 16 * w + c] : 0.f; \
        u32x4 p_; p_.x = pk2(wv[0], wv[1]); p_.y = pk2(wv[2], wv[3]); p_.z = pk2(wv[4], wv[5]); p_.w = pk2(wv[6], wv[7]); AZ[d_] = __builtin_bit_cast(bf16x8, p_); \
        BZ[d_] = *(const f32x4*)(a.g_bg + d_ * 512 + (h_) * 128 + 16 * w + 4 * q); } } while (0)
    int hcur;
    { const int n = u & (NCH - 1), h = (u >> 6) & 3, b = u >> 8; gla_load(R, proj, lrp, b, h, n, w, q, c); GLA_GATE_W(Az, bz, h); hcur = h; }
    for (; u < NU; u += G) {
        const int n = u & (NCH - 1), h = (u >> 6) & 3, b = u >> 8;
        if (h != hcur) { GLA_GATE_W(Az, bz, h); hcur = h; }
        { const int u2 = (u + G < NU) ? u + G : u; const int n2 = u2 & (NCH - 1), h2 = (u2 >> 6) & 3, b2 = u2 >> 8; gla_load(Rn, proj, lrp, b2, h2, n2, w, q, c); }
        gla_stage2(gla_img1(a, b, h, 0, n), gla_img1(a, b, h, 1, n), R, Az, bz, w, q, c);
        R = Rn;
    }
#undef GLA_GATE_W
}

__device__ __forceinline__ void gla_dma(LAS unsigned char* buf, const unsigned char* img1, const bf16* vsrc, int w, int lane) {
#pragma unroll
    for (int r = 0; r < (GL_NI1 + GL_NIV + 7) / 8; ++r) { const int k = w + 8 * r;
        if (k < GL_NI1) __builtin_amdgcn_global_load_lds((const unsigned*)(img1 + k * 1024 + lane * 16), (LAS unsigned*)(buf + k * 1024), 16, 0, 0);
        else if (k < GL_NI1 + GL_NIV) __builtin_amdgcn_global_load_lds((const unsigned*)(vsrc + (size_t)(8 * (k - GL_NI1) + (lane >> 3)) * ODD_PAD + (lane & 7) * 8), (LAS unsigned*)(buf + GL_VT + (k - GL_NI1) * 1024), 16, 0, 0); }
}
__device__ __forceinline__ void gla_phase(LAS unsigned char* lds, const Args& a, int G) {
    const int tid = threadIdx.x, lane = tid & 63, w = __builtin_amdgcn_readfirstlane(tid >> 6), q = lane >> 4, c = lane & 15;
    bf16* proj = (bf16*)(a.ws + WS_PROJ);
    const int I = w >> 1, E0 = 2 * (w & 1);
    for (int blk = blockIdx.x; blk < 256; blk += G) {
        const int xcd = blk & 7, idx = blk >> 3, sl = idx & 3, grp = xcd * 8 + (idx >> 2), dir = grp & 1, h = (grp >> 1) & 3, b = grp >> 3;
        bf16* O = (dir ? (bf16*)(a.ws + WS_OB2) : proj) + h * 256 + sl * 64;
        const int ostride = dir ? D : ODD_PAD;
        const bf16* vcol = proj + 1024 + h * 256 + sl * 64;
        f32x4 S[8][2];
#pragma unroll
        for (int dt = 0; dt < 8; ++dt) { S[dt][0] = (f32x4){0.f, 0.f, 0.f, 0.f}; S[dt][1] = (f32x4){0.f, 0.f, 0.f, 0.f}; }
        __syncthreads();
        { const int n = dir ? NCH - 1 : 0; gla_dma(lds, gla_img1(a, b, h, dir, n), vcol + ((size_t)b * SEQ + (size_t)n * CH) * ODD_PAD, w, lane); }
        asm volatile("s_waitcnt vmcnt(0)" ::: "memory"); RAW_BAR();
        for (int s = 0; s < NCH; ++s) {
            const int n = dir ? NCH - 1 - s : s;
            if (s + 1 < NCH) { const int n1 = dir ? n - 1 : n + 1; gla_dma(lds + ((s + 1) & 1) * GL_BUF, gla_img1(a, b, h, dir, n1), vcol + ((size_t)b * SEQ + (size_t)n1 * CH) * ODD_PAD, w, lane); }
            LAS unsigned char* buf = lds + (s & 1) * GL_BUF;
            const LAS bf16* QI = (const LAS bf16*)(buf + GL_QI); const LAS bf16* KI = (const LAS bf16*)(buf + GL_KI);
            const LAS unsigned char* VI = buf + GL_VT; const LAS float* DEC = (const LAS float*)(buf + GL_DEC);
            f32x4 sc[4];
#pragma unroll
            for (int jt = 0; jt < 4; ++jt) sc[jt] = (f32x4){0.f, 0.f, 0.f, 0.f};
#pragma unroll
            for (int ks = 0; ks < 4; ++ks) { const bf16x8 Bq = *(const LAS bf16x8*)(QI + (16 * I + c) * 136 + 32 * ks + 8 * q);
#pragma unroll
                for (int jt = 0; jt < 4; ++jt) { const bool live = dir ? (jt >= I) : (jt <= I);
                    if (live) { const bf16x8 Ak = *(const LAS bf16x8*)(KI + (16 * jt + c) * 136 + 32 * ks + 8 * q); sc[jt] = __builtin_amdgcn_mfma_f32_16x16x32_bf16(Ak, Bq, sc[jt], 0, 0, 0); } } }
#pragma unroll
            for (int jt = 0; jt < 4; ++jt) if (jt == I) {
#pragma unroll
                for (int r = 0; r < 4; ++r) { const bool keep = dir ? (4 * q + r >= c) : (4 * q + r <= c); if (!keep) sc[jt][r] = 0.f; } }
            const bf16x8 Bs0 = pack8(sc[0], sc[1]), Bs1 = pack8(sc[2], sc[3]);
#pragma unroll
            for (int e = 0; e < 2; ++e) { const int E = E0 + e;
                f32x4 oa = (f32x4){0.f, 0.f, 0.f, 0.f};
                oa = __builtin_amdgcn_mfma_f32_16x16x32_bf16(ld_tr8g(VI, 128, 4 * q, 16 + 4 * q, 16 * E, lane), Bs0, oa, 0, 0, 0);
                oa = __builtin_amdgcn_mfma_f32_16x16x32_bf16(ld_tr8g(VI, 128, 32 + 4 * q, 48 + 4 * q, 16 * E, lane), Bs1, oa, 0, 0, 0);
                const LAS bf16* qrow = QI + (16 * I + c) * 136;
#pragma unroll
                for (int ks = 0; ks < 4; ++ks) oa = __builtin_amdgcn_mfma_f32_16x16x32_bf16(pack8(S[2 * ks][e], S[2 * ks + 1][e]), ld2x8(qrow + 32 * ks + 4 * q, qrow + 32 * ks + 16 + 4 * q), oa, 0, 0, 0);
                const size_t tok = (size_t)b * SEQ + (size_t)n * CH + 16 * I + c;
                u32x2 o; o.x = pk2(oa[0], oa[1]); o.y = pk2(oa[2], oa[3]);
                *(u32x2*)(O + tok * ostride + 16 * E + 4 * q) = o;
            }
            __builtin_amdgcn_s_setprio(1);
#pragma unroll
            for (int cs = 0; cs < 2; ++cs) {
                const bf16x8 Bv0 = ld_tr8(VI, 128, 32 * cs, 16 * E0, lane), Bv1 = ld_tr8(VI, 128, 32 * cs, 16 * (E0 + 1), lane);
#pragma unroll
                for (int dt = 0; dt < 8; ++dt) { const bf16x8 Ak = ld_tr8(buf + GL_KI, 272, 32 * cs, 16 * dt, lane);
                    S[dt][0] = __builtin_amdgcn_mfma_f32_16x16x32_bf16(Ak, Bv0, S[dt][0], 0, 0, 0); S[dt][1] = __builtin_amdgcn_mfma_f32_16x16x32_bf16(Ak, Bv1, S[dt][1], 0, 0, 0); } }
            __builtin_amdgcn_s_setprio(0);
#pragma unroll
            for (int dt = 0; dt < 8; ++dt) { const f32x4 dc = *(const LAS f32x4*)(DEC + 16 * dt + 4 * q); S[dt][0] = S[dt][0] * dc; S[dt][1] = S[dt][1] * dc; }
            asm volatile("s_waitcnt vmcnt(2)" ::: "memory");
            RAW_BAR();
        }
    }
}

#define XB_TMO      128
#define XB_XCNT(j)  (256  + 64 * (j))
#define XB_XSUB(j)  (1280 + 64 * (j))
#define XB_XGEN(j)  (2304 + 64 * (j))
#define XB_TOP      3328
#define XB_TOPGEN   3392
#define XCD_BAR_WORDS 3456
#define XB_SPIN_CAP (1u << 20)
__device__ __forceinline__ unsigned xb_ld(unsigned* p)              { return __hip_atomic_load(p, __ATOMIC_RELAXED, __HIP_MEMORY_SCOPE_AGENT); }
__device__ __forceinline__ unsigned xb_add(unsigned* p, unsigned v) { return __hip_atomic_fetch_add(p, v, __ATOMIC_RELAXED, __HIP_MEMORY_SCOPE_AGENT); }
__device__ __forceinline__ unsigned xb_xcc_id() { return (unsigned)__builtin_amdgcn_s_getreg((3 << 11) | 20) & 0xFu; }
#define XB_SPIN(cond, bar) do { unsigned _sp = 0; while (cond) { __builtin_amdgcn_s_sleep(1); \
    if ((++_sp & 255u) == 0u) { if (xb_ld(&(bar)[XB_TMO])) break; if (_sp > XB_SPIN_CAP) { atomicAdd(&(bar)[XB_TMO], 1u); break; } } } } while (0)
struct XcdBarrier { unsigned* bar; unsigned x; volatile LAS unsigned* st; };
__device__ __forceinline__ XcdBarrier xcd_barrier_post(unsigned* bar, volatile LAS unsigned* st) {
    XcdBarrier b; b.bar = bar; b.x = xb_xcc_id(); b.st = st;
    if (threadIdx.x == 0) (void)xb_add(&bar[XB_XCNT(b.x)], 1u);
    return b;
}
__device__ __forceinline__ void xcd_barrier_complete(unsigned* bar, unsigned x, unsigned& nloc, unsigned& nx) {
    const unsigned G = gridDim.x * gridDim.y * gridDim.z;
    unsigned sum, cnt, mine, sp = 0u;
    for (;;) {
        sum = 0u; cnt = 0u; mine = 0u;
#pragma unroll
        for (unsigned j = 0; j < 16; ++j) { const unsigned c = xb_ld(&bar[XB_XCNT(j)]); sum += c; cnt += (c > 0u) ? 1u : 0u; mine = (j == x) ? c : mine; }
        if (sum == G) break;
        __builtin_amdgcn_s_sleep(1);
        if ((++sp & 255u) == 0u) { if (xb_ld(&bar[XB_TMO])) break; if (sp > XB_SPIN_CAP) { atomicAdd(&bar[XB_TMO], 1u); break; } }
    }
    nloc = mine > 0u ? mine : 1u; nx = cnt > 0u ? cnt : 1u;
}
__device__ __forceinline__ void xcd_barrier(const XcdBarrier& b) {
    asm volatile("s_waitcnt vmcnt(0)" ::: "memory");
    __syncthreads();
    if (threadIdx.x == 0) {
        unsigned* bar = b.bar;
        __builtin_amdgcn_s_waitcnt(0);
        unsigned nloc = b.st[0], nx = b.st[1];
        if (nloc == 0u) { xcd_barrier_complete(bar, b.x, nloc, nx); b.st[0] = nloc; b.st[1] = nx; }
        const unsigned old = xb_add(&bar[XB_XSUB(b.x)], 1u);
        const unsigned gen = old / nloc;
        if (old + 1u == (gen + 1u) * nloc) {
            __builtin_amdgcn_fence(__ATOMIC_RELEASE, "agent");
            asm volatile("s_waitcnt vmcnt(0)" ::: "memory");
            const unsigned og = xb_add(&bar[XB_TOP], 1u);
            const unsigned tg = og / nx;
            if (og + 1u == (tg + 1u) * nx) xb_add(&bar[XB_TOPGEN], 1u);
            else XB_SPIN(xb_ld(&bar[XB_TOPGEN]) == tg, bar);
            __builtin_amdgcn_fence(__ATOMIC_ACQUIRE, "agent");
            xb_add(&bar[XB_XGEN(b.x)], 1u);
            asm volatile("s_waitcnt vmcnt(0)" ::: "memory");
        } else {
            XB_SPIN(xb_ld(&bar[XB_XGEN(b.x)]) == gen, bar);
            __builtin_amdgcn_fence(__ATOMIC_ACQUIRE, "agent");
            asm volatile("s_waitcnt vmcnt(0)" ::: "memory");
        }
    }
    __syncthreads();
}

__global__ void __launch_bounds__(NT, 2) mega(Args a) {
    extern __shared__ __attribute__((aligned(16))) unsigned char lds_raw[];
    LAS unsigned char* lds = (LAS unsigned char*)lds_raw;
    const int G = gridDim.x;
    cg::grid_group grid = cg::this_grid();
    const int lo = a.ph_lo, hi = a.ph_hi;
#ifndef PHMASK
#define PHMASK 0xfff
#endif
#define IN(k) (((PHMASK >> (k)) & 1) && lo <= (k) && (k) < hi)
#define SEAM(k) do { if (IN(k) && IN((k) + 1)) xcd_barrier(xbar); } while (0)
    volatile LAS unsigned* xst = (volatile LAS unsigned*)(lds + 131072 + 64);
    if (threadIdx.x < 2) xst[threadIdx.x] = 0u;
    __syncthreads();
    XcdBarrier xbar = xcd_barrier_post((unsigned*)(a.ws + WS_CTL), xst);
    if (lo < 0) grid.sync();
    if (IN(0)) p0_prologue(lds, a, G);
    SEAM(0);
    if (IN(1)) { pg8::Gemm g{(const bf16*)a.out, (const bf16*)(a.ws + WS_W1), T, EVEN_IN, D}; pg8::StaticOrder S; S.init(T, EVEN_IN, G, (int)blockIdx.x);
        pg8::EpiBf16 E{(bf16*)(a.ws + WS_PROJ), EVEN_IN, 4, 8, 20, 24};   pg8::gemm_phase<pg8::EpiBf16, pg8::StaticOrder, true, true>(lds, g, S, E); }
    SEAM(1);
#ifndef REPMASK
#define REPMASK 0
#endif
#define REP(k) ((REPMASK >> (k)) & 1)
    if (IN(2)) { even_mixer<0>(lds, a, G); if (REP(2)) even_mixer<0>(lds, a, G); }
    SEAM(2);
    if (IN(3)) { even_mixer<1>(lds, a, G); if (REP(3)) even_mixer<1>(lds, a, G); }
    SEAM(3);
    if (IN(4)) { pg8::Gemm g{(const bf16*)a.out, (const bf16*)(a.ws + WS_W2), T, D, 2048}; pg8::StaticOrder S; S.init(T, D, G, (int)blockIdx.x);
        pg8::EpiBf16 E{(bf16*)(a.ws + WS_Y), D, 0, 0, 0, 0}; pg8::gemm_phase<pg8::EpiBf16, pg8::StaticOrder, true, true>(lds, g, S, E); }
    SEAM(4);
    if (IN(5)) p5_rows(lds, a, G);
    SEAM(5);
    if (IN(6)) { pg8::Gemm g{(const bf16*)(a.ws + WS_H1), (const bf16*)(a.ws + WS_W3), T, 3072, D}; pg8::StaticOrder S; S.init(T, 3072, G, (int)blockIdx.x);
        pg8::EpiBf16 E{(bf16*)(a.ws + WS_PROJ), ODD_PAD, 0, 0, 0, 0}; pg8::gemm_phase<pg8::EpiBf16, pg8::StaticOrder, true, true>(lds, g, S, E); }
    SEAM(6);
    if (IN(7)) gla_prep(lds, a, G);
    SEAM(7);
    if (IN(8)) { gla_phase(lds, a, G); if (REP(8)) gla_phase(lds, a, G); }
    SEAM(8);
    if (IN(9)) p8_rows(a, G);
    SEAM(9);
    if (IN(10)) { pg8::Gemm g{(const bf16*)(a.ws + WS_M1), (const bf16*)(a.ws + WS_W4), T, D, D}; pg8::StaticOrder S; S.init(T, D, G, (int)blockIdx.x);
        pg8::EpiBf16 E{(bf16*)(a.ws + WS_Y2), D, 0, 0, 0, 0}; pg8::gemm_phase<pg8::EpiBf16, pg8::StaticOrder, true, true>(lds, g, S, E); }
    SEAM(10);
    if (IN(11)) p10_rows(a, G);
#undef IN
#undef SEAM
}

extern "C" void kernel_launch(void* const* d_in, const int* in_sizes, int n_in, void* d_out, int out_size, void* d_ws, size_t ws_size, hipStream_t stream) {
    static int grid = 0;
    if (grid == 0) {
        if (n_in != 18 || in_sizes[0] != T * D || out_size != T * D || ws_size < WS_END) { fprintf(stderr, "kernel_launch: unexpected shapes / workspace (n_in %d, ws %zu)\n", n_in, ws_size); grid = -1; return; }
        int dev = 0, cus = 0, per_cu = 0;
        hipGetDevice(&dev); hipDeviceGetAttribute(&cus, hipDeviceAttributeMultiprocessorCount, dev);
        hipFuncSetAttribute((const void*)mega, hipFuncAttributeMaxDynamicSharedMemorySize, LDS_BYTES);
        hipOccupancyMaxActiveBlocksPerMultiprocessor(&per_cu, (const void*)mega, NT, LDS_BYTES);
        if (per_cu < 1) { fprintf(stderr, "kernel_launch: occupancy query reports %d blocks per CU\n", per_cu); grid = -1; return; }
        grid = cus;
        if (grid > 256) grid = 256;
    }
    if (grid < 0) return;
    Args a{};
    a.x = (const float*)d_in[0]; a.e_npre = (const float*)d_in[1]; a.e_npost = (const float*)d_in[2]; a.e_win = (const float*)d_in[3]; a.rg_cw = (const float*)d_in[4];
    a.rg_cb = (const float*)d_in[5]; a.rg_gw = (const float*)d_in[6]; a.rg_gb = (const float*)d_in[7]; a.rg_lam = (const float*)d_in[8]; a.sc_w = (const float*)d_in[9];
    a.e_wout = (const float*)d_in[10]; a.o_npre = (const float*)d_in[11]; a.o_npost = (const float*)d_in[12]; a.o_win = (const float*)d_in[13]; a.g_wlr = (const float*)d_in[14];
    a.g_bg = (const float*)d_in[15]; a.g_ng = (const float*)d_in[16]; a.o_wout = (const float*)d_in[17]; a.out = (float*)d_out; a.ws = (unsigned char*)d_ws;
#if MK_MULTI
    for (int p = 0; p <= 11; ++p) { a.ph_lo = p; a.ph_hi = p + 1; hipLaunchKernelGGL(mega, dim3(grid), dim3(NT), LDS_BYTES, stream, a); }
#else
    a.ph_lo = 0; a.ph_hi = 12;
    if (hipMemsetAsync((char*)d_ws + WS_CTL, 0, 16384, stream) != hipSuccess) { fprintf(stderr, "kernel_launch: memset failed\n"); return; }
    void* args[] = {&a};
    hipError_t e = hipLaunchCooperativeKernel((const void*)mega, dim3(grid), dim3(NT), args, LDS_BYTES, stream);
    if (e != hipSuccess) fprintf(stderr, "cooperative launch failed: %s (grid %d)\n", hipGetErrorString(e), grid);
#endif
}
```

```cpp
#include <hip/hip_runtime.h>
#include <hip/hip_cooperative_groups.h>
#include <cstdio>
#include <cstdint>
namespace cg = cooperative_groups;

#ifndef MK_MULTI
#define MK_MULTI 0
#endif

#define LAS __attribute__((address_space(3)))
typedef unsigned short bf16;
typedef short bf16x8 __attribute__((ext_vector_type(8)));
typedef float f32x4 __attribute__((ext_vector_type(4)));
typedef float f32x2 __attribute__((ext_vector_type(2)));
typedef unsigned u32x4 __attribute__((ext_vector_type(4)));
typedef unsigned u32x2 __attribute__((ext_vector_type(2)));

namespace pg8 {
typedef unsigned short bf16_t;
constexpr int BM = 256, BK = 64, HALF = 128, HTB = HALF * BK * 2, STAGE_BYTES = 8 * HTB, NXCD = 8, WGM = 8;
__host__ __device__ __forceinline__ int lds_byte(int r, int c) { const int st = (r >> 4) * 2 + (c >> 5), rr = r & 15, cc = c & 31, ob = rr * 64 + cc * 2; return st * 1024 + (ob ^ (((ob >> 9) & 1) << 5)); }
__host__ __device__ __forceinline__ void stage_rc(int b, int& R, int& C) { const int st = b / 1024, sb = b % 1024, swz = sb ^ (((sb >> 9) & 1) << 5); R = (st >> 1) * 16 + swz / 64; C = (st & 1) * 32 + (swz % 64) / 2; }
__host__ __device__ __forceinline__ int perm32(int rho) { const int n = rho >> 4, i = rho & 15; return 8 * (i >> 2) + 4 * n + (i & 3); }
struct Unit { int pm, pn; };
struct Gemm { const bf16_t* A; const bf16_t* Bt; int M, N, K; };
struct StaticOrder {
    int nM, nN, nwg, G, c;
    __host__ __device__ void init(int M, int N, int G_, int c_) { nM = M / BM; nN = N / BM; nwg = nM * nN; G = G_; c = c_; }
    __host__ __device__ bool next(int i, Unit& u) const {
        const long L = (long)i * G + c; if (L >= nwg) return false;
        int wgid = (int)L; { const int q = nwg / NXCD, r = nwg % NXCD, xcd = wgid % NXCD, off = wgid / NXCD; wgid = (xcd < r ? xcd * (q + 1) : r * (q + 1) + (xcd - r) * q) + off; }
        const int nig = WGM * nN, gid = wgid / nig, fm = gid * WGM, gsz = (nM - fm) < WGM ? (nM - fm) : WGM;
        u.pm = fm + ((wgid % nig) % gsz); u.pn = (wgid % nig) / gsz; return true;
    }
    __device__ __forceinline__ void a_ready(const Unit&) const {}
    __device__ __forceinline__ void done(const Unit&) const {}
};
typedef float f32x2_t __attribute__((ext_vector_type(2))); typedef __bf16 bf16x2_t __attribute__((ext_vector_type(2)));
__device__ __forceinline__ unsigned cvt_pk_bf16(float lo, float hi) { f32x2_t v = {lo, hi}; bf16x2_t b = __builtin_convertvector(v, bf16x2_t); return __builtin_bit_cast(unsigned, b); }
struct EpiBf16 {
    static constexpr bool PERM = true, AFTER_DRAIN = false;
    bf16_t* O; int ldc; int sa_lo, sa_hi, sb_lo, sb_hi;
    static __device__ __forceinline__ f32x4 silu4(const f32x4 v) { f32x4 r;
#pragma unroll
        for (int i = 0; i < 4; ++i) r[i] = v[i] * __builtin_amdgcn_rcpf(1.f + __builtin_amdgcn_exp2f(-1.4426950408889634f * v[i]));
        return r; }
    __device__ __forceinline__ void operator()(const f32x4 (&acc)[2][2][4][2], const Unit& u, int wr, int wc, int fr, int fq) const {
        const int row0 = u.pm * BM + wr * 64 + fr; const int col0 = u.pn * BM + wc * 32 + 8 * fq;
        const bool act = (u.pn >= sa_lo && u.pn < sa_hi) || (u.pn >= sb_lo && u.pn < sb_hi);
#pragma unroll
        for (int ai = 0; ai < 2; ++ai)
#pragma unroll
            for (int m = 0; m < 4; ++m) { bf16_t* rowp = O + (size_t)(row0 + ai * HALF + m * 16) * ldc + col0;
#pragma unroll
                for (int bj = 0; bj < 2; ++bj) { f32x4 v0 = acc[ai][bj][m][0], v1 = acc[ai][bj][m][1];
                    if (act) { v0 = silu4(v0); v1 = silu4(v1); }
                    u32x4 w; w.x = cvt_pk_bf16(v0[0], v0[1]); w.y = cvt_pk_bf16(v0[2], v0[3]); w.z = cvt_pk_bf16(v1[0], v1[1]); w.w = cvt_pk_bf16(v1[2], v1[3]);
                    *(u32x4*)(rowp + bj * HALF) = w; } }
    }
};
template <class Epi, class Sched, bool ALIGN_EPI = false, bool SP2 = false>
__device__ __forceinline__ void gemm_phase(LAS unsigned char* lds, const Gemm g, const Sched& S, const Epi& E) {
    const int tid = threadIdx.x, wid = __builtin_amdgcn_readfirstlane(tid >> 6), lane = tid & 63, wr = wid >> 2, wc = wid & 3, fr = lane & 15, fq = lane >> 4;
    const int K = g.K, nt = K / BK;
    unsigned voffA[2], voffB[2];
#pragma unroll
    for (int i = 0; i < 2; ++i) { int R, C; stage_rc(tid * 16 + i * 8192, R, C); const int Rb = Epi::PERM ? ((R & ~31) + perm32(R & 31)) : R;
        voffA[i] = (unsigned)(R * K + C) * 2u; voffB[i] = (unsigned)(Rb * K + C) * 2u; }
    const size_t kstep = (size_t)(BK * 2);
    const size_t hstep = (size_t)HALF * K * 2;
    const size_t tstep = 2 * hstep;
    const unsigned ldsw = (unsigned)wid * 1024u;
    const int aoff = lds_byte(wr * 64 + fr, fq * 8), boff = lds_byte(wc * 32 + fr, fq * 8);
#define PG8_SA(b, h) (((b) * 2 + (h)) * HTB)
#define PG8_SB(b, h) ((4 + (b) * 2 + (h)) * HTB)
#define PG8_STAGE(bufoff, gbase, voff) do { _Pragma("unroll") for (int _i = 0; _i < 2; ++_i) \
        __builtin_amdgcn_global_load_lds((const unsigned*)((const char*)(gbase) + (voff)[_i]), (LAS unsigned*)(lds + (bufoff) + ldsw + _i * 8192), 16, 0, 0); } while (0)
#define PG8_LDA(dst, b, h) do { _Pragma("unroll") for (int m = 0; m < 4; ++m) _Pragma("unroll") for (int k = 0; k < 2; ++k) dst[m][k] = *(const LAS bf16x8*)(lds + PG8_SA(b, h) + aoff + m * 2048 + k * 1024); } while (0)
#define PG8_LDB(dst, b, h) do { _Pragma("unroll") for (int n = 0; n < 2; ++n) _Pragma("unroll") for (int k = 0; k < 2; ++k) dst[n][k] = *(const LAS bf16x8*)(lds + PG8_SB(b, h) + boff + n * 2048 + k * 1024); } while (0)
#define PG8_MMA(ai, bj, At, Bt) do { __builtin_amdgcn_s_setprio(1); _Pragma("unroll") for (int m = 0; m < 4; ++m) _Pragma("unroll") for (int n = 0; n < 2; ++n) _Pragma("unroll") for (int k = 0; k < 2; ++k) \
        acc[ai][bj][m][n] = __builtin_amdgcn_mfma_f32_16x16x32_bf16(Bt[n][k], At[m][k], acc[ai][bj][m][n], 0, 0, 0); __builtin_amdgcn_s_setprio(0); } while (0)
#define PG8_WAIT_V(n) asm volatile("s_waitcnt vmcnt(" #n ")" ::: "memory")
#define PG8_WAIT_L(n) asm volatile("s_waitcnt lgkmcnt(" #n ")" ::: "memory")
#define PG8_BAR __builtin_amdgcn_s_barrier()
#define PG8_SCHED __builtin_amdgcn_sched_barrier(0)
    Unit cur, nxt; int ui = 0;
    if (!S.next(0, cur)) return;
    f32x4 acc[2][2][4][2];
#pragma unroll
    for (int a = 0; a < 2; ++a)
#pragma unroll
        for (int b = 0; b < 2; ++b)
#pragma unroll
            for (int m = 0; m < 4; ++m)
#pragma unroll
                for (int n = 0; n < 2; ++n) acc[a][b][m][n] = (f32x4){0.f, 0.f, 0.f, 0.f};
    bf16x8 At[4][2], B0[2][2], B1[2][2];
    const char* cA = (const char*)g.A + (size_t)cur.pm * tstep; const char* cB = (const char*)g.Bt + (size_t)cur.pn * tstep;
    S.a_ready(cur);
    if constexpr (SP2) {
        PG8_STAGE(PG8_SB(0, 0), cB, voffB); PG8_STAGE(PG8_SB(0, 1), cB + hstep, voffB); PG8_STAGE(PG8_SA(0, 0), cA, voffA); PG8_STAGE(PG8_SA(0, 1), cA + hstep, voffA);
        if (wr == 1) PG8_BAR;
        PG8_WAIT_V(2); PG8_BAR;
        PG8_STAGE(PG8_SB(1, 0), cB + kstep, voffB); PG8_STAGE(PG8_SA(1, 0), cA + kstep, voffA); PG8_STAGE(PG8_SB(1, 1), cB + hstep + kstep, voffB);
        PG8_WAIT_V(6); PG8_BAR;
    } else {
        PG8_STAGE(PG8_SB(0, 0), cB, voffB); PG8_STAGE(PG8_SA(0, 0), cA, voffA); PG8_STAGE(PG8_SB(0, 1), cB + hstep, voffB); PG8_STAGE(PG8_SA(0, 1), cA + hstep, voffA);
        if (wr == 1) PG8_BAR;
        PG8_WAIT_V(4); PG8_BAR;
        PG8_STAGE(PG8_SB(1, 0), cB + kstep, voffB); PG8_STAGE(PG8_SA(1, 0), cA + kstep, voffA); PG8_STAGE(PG8_SB(1, 1), cB + hstep + kstep, voffB);
        PG8_WAIT_V(6); PG8_BAR;
    }
    for (;;) {
        const bool has_next = S.next(ui + 1, nxt);
        const char* nA = has_next ? (const char*)g.A + (size_t)nxt.pm * tstep : cA; const char* nB = has_next ? (const char*)g.Bt + (size_t)nxt.pn * tstep : cB;
        for (int t = 0; t < nt; t += 2) {
            const bool last = (t == nt - 2);
            const char* a1 = cA + (size_t)(t + 1) * kstep;
            const char* a2 = last ? nA : cA + (size_t)(t + 2) * kstep; const char* b2 = last ? nB : cB + (size_t)(t + 2) * kstep;
            const char* a3 = a2 + kstep; const char* b3 = b2 + kstep;
            if (last && has_next) S.a_ready(nxt);
            if constexpr (SP2) {
            PG8_LDB(B0, 0, 0); PG8_LDB(B1, 0, 1); PG8_SCHED; PG8_LDA(At, 0, 0); PG8_STAGE(PG8_SA(1, 1), a1 + hstep, voffA);
            PG8_WAIT_V(8); PG8_WAIT_L(0); PG8_BAR; PG8_MMA(0, 0, At, B0); PG8_MMA(0, 1, At, B1); PG8_BAR; PG8_SCHED;
            PG8_LDA(At, 0, 1); PG8_STAGE(PG8_SB(0, 0), b2, voffB); PG8_STAGE(PG8_SB(0, 1), b2 + hstep, voffB); PG8_STAGE(PG8_SA(0, 0), a2, voffA);
            PG8_WAIT_V(8); PG8_WAIT_L(0); PG8_BAR; PG8_MMA(1, 0, At, B0); PG8_MMA(1, 1, At, B1); PG8_BAR; PG8_SCHED;
            PG8_LDB(B0, 1, 0); PG8_LDB(B1, 1, 1); PG8_SCHED; PG8_LDA(At, 1, 0); PG8_STAGE(PG8_SA(0, 1), a2 + hstep, voffA);
            PG8_WAIT_V(8); PG8_WAIT_L(0); PG8_BAR; PG8_MMA(0, 0, At, B0); PG8_MMA(0, 1, At, B1); PG8_BAR; PG8_SCHED;
            PG8_LDA(At, 1, 1); PG8_STAGE(PG8_SB(1, 0), b3, voffB); PG8_STAGE(PG8_SB(1, 1), b3 + hstep, voffB); PG8_STAGE(PG8_SA(1, 0), a3, voffA);
            PG8_WAIT_V(8); PG8_WAIT_L(0); PG8_BAR; PG8_MMA(1, 0, At, B0); PG8_MMA(1, 1, At, B1); PG8_BAR; PG8_SCHED;
            } else {
            PG8_LDB(B0, 0, 0); PG8_SCHED; PG8_LDA(At, 0, 0); PG8_STAGE(PG8_SA(1, 1), a1 + hstep, voffA);
            PG8_WAIT_L(8); PG8_BAR; PG8_WAIT_L(0); PG8_MMA(0, 0, At, B0); PG8_BAR; PG8_SCHED;
            PG8_LDB(B1, 0, 1); PG8_STAGE(PG8_SB(0, 0), b2, voffB);
            PG8_BAR; PG8_WAIT_L(0); PG8_MMA(0, 1, At, B1); PG8_BAR;
            PG8_LDA(At, 0, 1); PG8_STAGE(PG8_SA(0, 0), a2, voffA);
            PG8_BAR; PG8_WAIT_L(0); PG8_MMA(1, 0, At, B0); PG8_BAR; PG8_SCHED;
            PG8_STAGE(PG8_SB(0, 1), b2 + hstep, voffB);
            PG8_WAIT_V(6); PG8_BAR; PG8_MMA(1, 1, At, B1); PG8_BAR;
            PG8_LDB(B0, 1, 0); PG8_SCHED; PG8_LDA(At, 1, 0); PG8_STAGE(PG8_SA(0, 1), a2 + hstep, voffA);
            PG8_WAIT_L(8); PG8_BAR; PG8_WAIT_L(0); PG8_MMA(0, 0, At, B0); PG8_BAR; PG8_SCHED;
            PG8_LDB(B1, 1, 1); PG8_STAGE(PG8_SB(1, 0), b3, voffB);
            PG8_BAR; PG8_WAIT_L(0); PG8_MMA(0, 1, At, B1); PG8_BAR;
            PG8_LDA(At, 1, 1); PG8_STAGE(PG8_SA(1, 0), a3, voffA);
            PG8_BAR; PG8_WAIT_L(0); PG8_MMA(1, 0, At, B0); PG8_BAR; PG8_SCHED;
            PG8_STAGE(PG8_SB(1, 1), b3 + hstep, voffB);
            PG8_WAIT_V(6); PG8_BAR; PG8_MMA(1, 1, At, B1); PG8_BAR;
            }
        }
        if constexpr (ALIGN_EPI) { if (wr == 0) PG8_BAR; }
        if constexpr (!Epi::AFTER_DRAIN) { E(acc, cur, wr, wc, fr, fq); S.done(cur); }
        if (!has_next) break;
#pragma unroll
        for (int a = 0; a < 2; ++a)
#pragma unroll
            for (int b = 0; b < 2; ++b)
#pragma unroll
                for (int m = 0; m < 4; ++m)
#pragma unroll
                    for (int n = 0; n < 2; ++n) acc[a][b][m][n] = (f32x4){0.f, 0.f, 0.f, 0.f};
        cur = nxt; cA = nA; cB = nB; ++ui;
        if constexpr (ALIGN_EPI) { if (wr == 1) PG8_BAR; }
    }
    PG8_WAIT_V(0);
    if constexpr (!ALIGN_EPI) { if (wr == 0) PG8_BAR; }
    PG8_BAR;
#undef PG8_SA
#undef PG8_SB
#undef PG8_STAGE
#undef PG8_LDA
#undef PG8_LDB
#undef PG8_MMA
#undef PG8_WAIT_V
#undef PG8_WAIT_L
#undef PG8_BAR
#undef PG8_SCHED
}
}

constexpr int NB = 8, SEQ = 4096, D = 1024, T = NB * SEQ;
constexpr int EVEN_IN = 6144, ODD_IN = 3104, ODD_PAD = 3328;
constexpr int CH = 64, NCH = SEQ / CH;
constexpr float EPS = 1e-6f;
constexpr int NT = 512, NWAVES = 8;
constexpr int LDS_BYTES = 147456;

constexpr size_t MiB = 1u << 20;
constexpr size_t WS_W1 = 0;
constexpr size_t WS_W2 = 12 * MiB;
constexpr size_t WS_W3 = 16 * MiB;
constexpr size_t WS_W4 = 23 * MiB;
constexpr size_t WS_GW = 25 * MiB;
constexpr size_t WS_SUMF = 26 * MiB;
constexpr size_t WS_SUMB = 30 * MiB;
constexpr size_t WS_CTL = 36 * MiB;
constexpr size_t WS_LR = 37 * MiB;
constexpr size_t WS_PROJ = 40 * MiB;
constexpr size_t WS_IMG1B = 248 * MiB;
constexpr size_t WS_OB2 = 354 * MiB;
constexpr size_t WS_H1 = 376 * MiB;
constexpr size_t WS_M1 = 248 * MiB;
constexpr size_t WS_Y2 = 312 * MiB;
constexpr size_t WS_Y = 440 * MiB;
constexpr size_t WS_END = 504 * MiB;

__device__ __forceinline__ unsigned pk2(float lo, float hi) { return pg8::cvt_pk_bf16(lo, hi); }
__device__ __forceinline__ float bflo(unsigned u) { return __uint_as_float(u << 16); }
__device__ __forceinline__ float bfhi(unsigned u) { return __uint_as_float(u & 0xffff0000u); }
__device__ __forceinline__ float wave_sum(float v) {
#pragma unroll
    for (int o = 1; o < 64; o <<= 1) v += __shfl_xor(v, o);
    return v;
}
__device__ __forceinline__ float sigmoidf_(float x) { return __builtin_amdgcn_rcpf(1.f + __expf(-x)); }
__device__ __forceinline__ float siluf_(float x) { return x * sigmoidf_(x); }
#define LDS_WAIT() asm volatile("s_waitcnt lgkmcnt(0)" ::: "memory")

__device__ __forceinline__ void p0_transpose_item(const float* W, int K, int N, bf16* WT, LAS float* scr, int item, int lane, float scale = 1.f) {
    const int nblk = N / 32, kb = item / nblk, nb = item % nblk, k0 = 64 * kb, n0 = 32 * nb;
#pragma unroll 8
    for (int i = 0; i < 32; ++i) { const int kk = 2 * i + (lane >> 5); scr[kk * 33 + (lane & 31)] = W[(size_t)(k0 + kk) * N + n0 + (lane & 31)] * scale; }
    LDS_WAIT(); asm volatile("" ::: "memory");
    const int c = lane & 7;
#pragma unroll
    for (int j = 0; j < 4; ++j) { const int n = (lane >> 3) + 8 * j; const LAS float* s = scr + (8 * c) * 33 + n;
        u32x4 o; o.x = pk2(s[0 * 33], s[1 * 33]); o.y = pk2(s[2 * 33], s[3 * 33]); o.z = pk2(s[4 * 33], s[5 * 33]); o.w = pk2(s[6 * 33], s[7 * 33]);
        *(u32x4*)(WT + (size_t)(n0 + n) * K + k0 + 8 * c) = o; }
    LDS_WAIT(); asm volatile("" ::: "memory");
}

__device__ __forceinline__ void row_load(const float* row, int lane, f32x4 (&v)[4]) {
    const f32x4* p = (const f32x4*)row + lane;
#pragma unroll
    for (int j = 0; j < 4; ++j) v[j] = p[64 * j];
}
__device__ __forceinline__ void row_load_bf16(const bf16* row, int lane, f32x4 (&v)[4]) {
    const u32x2* p = (const u32x2*)row + lane;
#pragma unroll
    for (int j = 0; j < 4; ++j) { const u32x2 w = p[64 * j]; v[j] = (f32x4){bflo(w.x), bfhi(w.x), bflo(w.y), bfhi(w.y)}; }
}
__device__ __forceinline__ float row_sumsq(const f32x4 (&v)[4]) {
    float s = 0.f;
#pragma unroll
    for (int j = 0; j < 4; ++j) s += (v[j].x * v[j].x + v[j].y * v[j].y) + (v[j].z * v[j].z + v[j].w * v[j].w);
    return wave_sum(s);
}
__device__ __forceinline__ void row_store_bf16(bf16* row, int lane, const f32x4 (&v)[4]) {
    u32x2* p = (u32x2*)row + lane;
#pragma unroll
    for (int j = 0; j < 4; ++j) { u32x2 w; w.x = pk2(v[j].x, v[j].y); w.y = pk2(v[j].z, v[j].w); p[64 * j] = w; }
}

struct Args {
    const float* x; const float* e_npre; const float* e_npost; const float* e_win; const float* rg_cw; const float* rg_cb; const float* rg_gw; const float* rg_gb;
    const float* rg_lam; const float* sc_w; const float* e_wout; const float* o_npre; const float* o_npost; const float* o_win; const float* g_wlr; const float* g_bg;
    const float* g_ng; const float* o_wout; float* out; unsigned char* ws; int ph_lo, ph_hi;
};

__device__ __forceinline__ void p0_prologue(LAS unsigned char* lds, const Args& a, int G) {
    const int tid = threadIdx.x, lane = tid & 63, wave = tid >> 6;
    LAS float* scr = (LAS float*)(lds + wave * 16384);
    const int gw = blockIdx.x * NWAVES + wave, NGW = G * NWAVES;
    constexpr int I1 = (D / 64) * (EVEN_IN / 32), I2 = (2048 / 64) * (D / 32), I3 = (D / 64) * (ODD_IN / 32), I4 = (D / 64) * (D / 32), I5 = 32 * 8;
    constexpr int NITEMS = I1 + I2 + I3 + I4 + I5;
    bf16* W1 = (bf16*)(a.ws + WS_W1); bf16* W2 = (bf16*)(a.ws + WS_W2); bf16* W3 = (bf16*)(a.ws + WS_W3); bf16* W4 = (bf16*)(a.ws + WS_W4); bf16* GW = (bf16*)(a.ws + WS_GW);
    for (int it = gw; it < NITEMS; it += NGW) {
        int r = it;
        if (r < I1) { p0_transpose_item(a.e_win, D, EVEN_IN, W1, scr, r, lane); continue; } r -= I1;
        if (r < I2) { p0_transpose_item(a.e_wout, 2048, D, W2, scr, r, lane); continue; } r -= I2;
        if (r < I3) { p0_transpose_item(a.o_win, D, ODD_IN, W3, scr, r, lane); continue; } r -= I3;
        if (r < I4) { p0_transpose_item(a.o_wout, D, D, W4, scr, r, lane); continue; } r -= I4;
        { const int m = r >> 3; p0_transpose_item(a.rg_gw + (size_t)m * 16384, 128, 128, GW + (size_t)m * 16384, scr, r & 7, lane, -1.4426950408889634f); }
    }
    { u32x4* z = (u32x4*)(W3 + (size_t)ODD_IN * D); const int n16 = (ODD_PAD - ODD_IN) * D * 2 / 16;
      for (int i = blockIdx.x * NT + tid; i < n16; i += G * NT) z[i] = (u32x4){0u, 0u, 0u, 0u}; }
    bf16* H0 = (bf16*)a.out;
    f32x4 gg[4]; row_load(a.e_npre, lane, gg);
    for (int m = gw; m < T; m += NGW) {
        f32x4 v[4]; row_load(a.x + (size_t)m * D, lane, v);
        const float rs = rsqrtf(row_sumsq(v) * (1.f / D) + EPS);
#pragma unroll
        for (int j = 0; j < 4; ++j) v[j] = v[j] * rs * gg[j];
        row_store_bf16(H0 + (size_t)m * D, lane, v);
    }
}

constexpr int EM_UB = 0, EM_CF = 51200, EM_CB = 59392;
template <int CTRL> __device__ __forceinline__ float dpp_f(float oldv, float src) {
    return __int_as_float(__builtin_amdgcn_update_dpp(__float_as_int(oldv), __float_as_int(src), CTRL, 0xf, 0xf, false));
}
template <bool BWD> __device__ __forceinline__ void row_scan(float& a, float& b) {
    if (!BWD) {
        { const float a2 = dpp_f<0x111>(1.f, a), b2 = dpp_f<0x111>(0.f, b); b = a * b2 + b; a = a * a2; }
        { const float a2 = dpp_f<0x112>(1.f, a), b2 = dpp_f<0x112>(0.f, b); b = a * b2 + b; a = a * a2; }
        { const float a2 = dpp_f<0x114>(1.f, a), b2 = dpp_f<0x114>(0.f, b); b = a * b2 + b; a = a * a2; }
        { const float a2 = dpp_f<0x118>(1.f, a), b2 = dpp_f<0x118>(0.f, b); b = a * b2 + b; a = a * a2; }
    } else {
        { const float a2 = dpp_f<0x101>(1.f, a), b2 = dpp_f<0x101>(0.f, b); b = a * b2 + b; a = a * a2; }
        { const float a2 = dpp_f<0x102>(1.f, a), b2 = dpp_f<0x102>(0.f, b); b = a * b2 + b; a = a * a2; }
        { const float a2 = dpp_f<0x104>(1.f, a), b2 = dpp_f<0x104>(0.f, b); b = a * b2 + b; a = a * a2; }
        { const float a2 = dpp_f<0x108>(1.f, a), b2 = dpp_f<0x108>(0.f, b); b = a * b2 + b; a = a * a2; }
    }
}

#define RAW_BAR() do { asm volatile("s_waitcnt lgkmcnt(0)" ::: "memory"); __builtin_amdgcn_s_barrier(); asm volatile("" ::: "memory"); } while (0)
constexpr int EM_BUF = 17408;
constexpr int EM_CF2 = 2 * EM_BUF, EM_CB2 = EM_CF2 + 8192, EM_CW = EM_CB2 + 8192, EM_GB = EM_CW + 2560, EM_SP = EM_GB + 2048, EM_GW0 = EM_SP + 1024;
struct EmRaw { u32x4 v[4][2]; };
__device__ __forceinline__ void em_load(EmRaw& R, const bf16* proj, int b, int head, int n, int tid) {
    const int t = tid >> 3, cgp = tid & 7, tseq = n * CH + t, chs = head * 128 + cgp * 16;
#pragma unroll
    for (int k = 0; k < 4; ++k) { int ts = tseq + k - 2; ts = ts < 0 ? 0 : (ts >= SEQ ? SEQ - 1 : ts);
        const bf16* row = proj + ((size_t)b * SEQ + ts) * EVEN_IN + chs;
        R.v[k][0] = *(const u32x4*)row; R.v[k][1] = *(const u32x4*)(row + 8); }
}
__device__ __forceinline__ void em_conv(LAS unsigned char* buf, const LAS float* CW, const EmRaw& R, int n, int tid) {
    const int t = tid >> 3, cgp = tid & 7, tseq = n * CH + t;
    float u[16];
#pragma unroll
    for (int e4 = 0; e4 < 4; ++e4) { const f32x4 bb = *(const LAS f32x4*)(CW + 4 * 128 + cgp * 16 + 4 * e4); u[4 * e4] = bb.x; u[4 * e4 + 1] = bb.y; u[4 * e4 + 2] = bb.z; u[4 * e4 + 3] = bb.w; }
#pragma unroll
    for (int k = 0; k < 4; ++k) { const int ts = tseq + k - 2; const float m = (ts >= 0 && ts < SEQ) ? 1.f : 0.f;
        const u32x4 v0 = R.v[k][0], v1 = R.v[k][1];
        const LAS float* wk = CW + k * 128 + cgp * 16;
        f32x4 w0 = *(const LAS f32x4*)wk, w1 = *(const LAS f32x4*)(wk + 4), w2 = *(const LAS f32x4*)(wk + 8), w3 = *(const LAS f32x4*)(wk + 12);
        w0 = w0 * m; w1 = w1 * m; w2 = w2 * m; w3 = w3 * m;
        u[0] += w0.x * bflo(v0.x); u[1] += w0.y * bfhi(v0.x); u[2] += w0.z * bflo(v0.y); u[3] += w0.w * bfhi(v0.y);
        u[4] += w1.x * bflo(v0.z); u[5] += w1.y * bfhi(v0.z); u[6] += w1.z * bflo(v0.w); u[7] += w1.w * bfhi(v0.w);
        u[8] += w2.x * bflo(v1.x); u[9] += w2.y * bfhi(v1.x); u[10] += w2.z * bflo(v1.y); u[11] += w2.w * bfhi(v1.y);
        u[12] += w3.x * bflo(v1.z); u[13] += w3.y * bfhi(v1.z); u[14] += w3.z * bflo(v1.w); u[15] += w3.w * bfhi(v1.w);
    }
    const int rho = (t & 3) | (((t >> 4) & 3) << 2) | (((t >> 2) & 3) << 4);
    LAS u32x4* ub = (LAS u32x4*)((LAS bf16*)(buf + EM_UB) + rho * 136 + cgp * 16);
    ub[0] = (u32x4){pk2(u[0], u[1]), pk2(u[2], u[3]), pk2(u[4], u[5]), pk2(u[6], u[7])};
    ub[1] = (u32x4){pk2(u[8], u[9]), pk2(u[10], u[11]), pk2(u[12], u[13]), pk2(u[14], u[15])};
}

struct BbRaw { u32x4 xb[3], gc[3], gb, zb; };
__device__ __forceinline__ void bb_load(BbRaw& B, const bf16* proj, int m, int chb) {
    const int tseq = m & (SEQ - 1);
#pragma unroll
    for (int k = 0; k < 3; ++k) { int ts = tseq + k - 1; ts = ts < 0 ? 0 : (ts >= SEQ ? SEQ - 1 : ts);
        const bf16* row = proj + (size_t)(m - tseq + ts) * EVEN_IN + chb;
        B.xb[k] = *(const u32x4*)(row + 2048); B.gc[k] = *(const u32x4*)(row + 4096); }
    const bf16* row = proj + (size_t)m * EVEN_IN + chb;
    B.gb = *(const u32x4*)(row + 3072); B.zb = *(const u32x4*)(row + 5120);
}
__device__ __forceinline__ void bb_compute(const BbRaw& B, const f32x4 (&wsc)[3][2], bf16* mix, int m, int chb, bool ok = true) {
    const int tseq = m & (SEQ - 1);
    float cv[8];
#pragma unroll
    for (int e = 0; e < 8; ++e) cv[e] = 0.f;
#pragma unroll
    for (int k = 0; k < 3; ++k) { const int ts = tseq + k - 1; const float msk = (ts >= 0 && ts < SEQ) ? 1.f : 0.f;
        const u32x4 xb = B.xb[k], gc = B.gc[k];
        const f32x4 w0 = wsc[k][0] * msk, w1 = wsc[k][1] * msk;
        cv[0] += w0.x * bflo(xb.x) * bflo(gc.x); cv[1] += w0.y * bfhi(xb.x) * bfhi(gc.x); cv[2] += w0.z * bflo(xb.y) * bflo(gc.y); cv[3] += w0.w * bfhi(xb.y) * bfhi(gc.y);
        cv[4] += w1.x * bflo(xb.z) * bflo(gc.z); cv[5] += w1.y * bfhi(xb.z) * bfhi(gc.z); cv[6] += w1.z * bflo(xb.w) * bflo(gc.w); cv[7] += w1.w * bfhi(xb.w) * bfhi(gc.w);
    }
    const u32x4 gb = B.gb, zb = B.zb;
    u32x4 o;
    o.x = pk2(bflo(gb.x) * cv[0] * bflo(zb.x), bfhi(gb.x) * cv[1] * bfhi(zb.x));
    o.y = pk2(bflo(gb.y) * cv[2] * bflo(zb.y), bfhi(gb.y) * cv[3] * bfhi(zb.y));
    o.z = pk2(bflo(gb.z) * cv[4] * bflo(zb.z), bfhi(gb.z) * cv[5] * bfhi(zb.z));
    o.w = pk2(bflo(gb.w) * cv[6] * bflo(zb.w), bfhi(gb.w) * cv[7] * bfhi(zb.w));
    if (ok) *(u32x4*)(mix + (size_t)m * 2048 + 1024 + chb) = o;
}

template <int PASS>
__device__ __forceinline__ void even_mixer(LAS unsigned char* lds, const Args& a, int G) {
    const int tid = threadIdx.x, lane = tid & 63, w = __builtin_amdgcn_readfirstlane(tid >> 6), q = lane >> 4, c = lane & 15;
    const bf16* proj = (const bf16*)(a.ws + WS_PROJ);
    bf16* mix = (bf16*)a.out;
    f32x2* sumF = (f32x2*)(a.ws + WS_SUMF); f32x2* sumB = (f32x2*)(a.ws + WS_SUMB);
    const bf16* gwt = (const bf16*)(a.ws + WS_GW);
    LAS float* CF = (LAS float*)(lds + EM_CF2); LAS float* CB = (LAS float*)(lds + EM_CB2); LAS float* CW = (LAS float*)(lds + EM_CW);
    const int gtid = blockIdx.x * NT + tid, chb = (gtid & 127) * 8, mstride = (G * NT) >> 7;
    int mb = gtid >> 7;
    f32x4 wsc[3][2];
    if (PASS == 0) {
#pragma unroll
        for (int k = 0; k < 3; ++k) { wsc[k][0] = *(const f32x4*)(a.sc_w + k * 1024 + chb); wsc[k][1] = *(const f32x4*)(a.sc_w + k * 1024 + chb + 4); }
    }
    for (int seg = blockIdx.x; seg < 256; seg += G) {
        const int head = seg & 7, b = (seg >> 3) & 7, n0 = (seg >> 6) * 16;
        const int j0 = 16 * w + 4 * q;
        const int ch0 = head * 128 + j0;
        __syncthreads();
        for (int i = tid; i < 5 * 128; i += NT) { const int k = i >> 7, j = i & 127; CW[i] = (k < 4) ? a.rg_cw[k * 1024 + head * 128 + j] : a.rg_cb[head * 128 + j]; }
        for (int i = tid; i < 4096; i += NT) { const int cb = i >> 11, j = (i >> 4) & 127, ch16 = i & 15;
            *(LAS u32x4*)(lds + EM_GW0 + (cb * 128 + j) * 272 + ch16 * 16) = *(const u32x4*)(gwt + (size_t)(cb * 8 + head) * 16384 + j * 128 + ch16 * 8); }
        { LAS float* GBs = (LAS float*)(lds + EM_GB); LAS float* SPs = (LAS float*)(lds + EM_SP);
          { const int cb = tid >> 7, j = tid & 127; GBs[tid] = -1.4426950408889634f * a.rg_gb[(cb * 8 + head) * 128 + j]; }
          if (tid < 256) { const int d = tid >> 7, j = tid & 127; SPs[tid] = -8.f * 1.4426950408889634f * log1pf(expf(-a.rg_lam[d * 1024 + head * 128 + j])); } }
        if (PASS == 1) {
            if (tid < 256) {
                const int dir = tid >> 7, j = tid & 127, ch = head * 128 + j;
                float h = 0.f;
                if (dir == 0) {
                    for (int m0 = 0; m0 < n0 + 16; m0 += 16) {
                        f32x2 sv[16];
#pragma unroll
                        for (int k = 0; k < 16; ++k) sv[k] = sumF[((size_t)(b * NCH + m0 + k)) * 1024 + ch];
                        const bool mine = (m0 == n0);
#pragma unroll
                        for (int k = 0; k < 16; ++k) { if (mine) CF[k * 128 + j] = h; h = sv[k].x * h + sv[k].y; }
                    }
                } else {
                    for (int m0 = NCH - 16; m0 >= n0; m0 -= 16) {
                        f32x2 sv[16];
#pragma unroll
                        for (int k = 0; k < 16; ++k) sv[k] = sumB[((size_t)(b * NCH + m0 + 15 - k)) * 1024 + ch];
                        const bool mine = (m0 == n0);
#pragma unroll
                        for (int k = 0; k < 16; ++k) { if (mine) CB[(15 - k) * 128 + j] = h; h = sv[k].x * h + sv[k].y; }
                    }
                }
            }
        }
        EmRaw R, Rn;
        em_load(R, proj, b, head, n0, tid);
        __syncthreads();
        em_conv(lds, CW, R, n0, tid);
        em_load(R, proj, b, head, n0 + 1, tid);
        RAW_BAR();
        for (int ci = 0; ci < 16; ++ci) {
            const int n = n0 + ci; const size_t tok0 = (size_t)b * SEQ + (size_t)n * CH;
            LAS unsigned char* buf = lds + (ci & 1) * EM_BUF;
            const LAS bf16* UB = (const LAS bf16*)(buf + EM_UB);
            int aoff = (head * 128 + 16 * w + c) * 128 + 8 * q;
            asm volatile("" : "+v"(aoff));
            bf16x8 Af1[2][4];
            BbRaw Bq;
            if (PASS == 0) bb_load(Bq, proj, mb < T ? mb : T - 1, chb);
            unsigned short zav[4][4];
            if (PASS == 1) {
#pragma unroll
                for (int tt = 0; tt < 4; ++tt)
#pragma unroll
                    for (int r = 0; r < 4; ++r) zav[tt][r] = *(const unsigned short*)(proj + (tok0 + 16 * q + 4 * tt + r) * EVEN_IN + 1024 + head * 128 + 16 * w + c);
            }
            { const int n2 = (ci + 2 < 16) ? n + 2 : n0 + 15; em_load(Rn, proj, b, head, n2, tid); }
            em_conv(lds + ((ci + 1) & 1) * EM_BUF, CW, R, n + 1, tid);
            const int chl = 16 * w + c;
            f32x4 z[4][4];
#pragma unroll
            for (int d = 0; d < 2; ++d) {
                const float gbr = ((const LAS float*)(lds + EM_GB))[(2 * d) * 128 + chl], gbi = ((const LAS float*)(lds + EM_GB))[(2 * d + 1) * 128 + chl];
                const float sp = ((const LAS float*)(lds + EM_SP))[d * 128 + chl];
#pragma unroll
                for (int tt = 0; tt < 4; ++tt) { z[2 * d][tt] = (f32x4){gbr, gbr, gbr, gbr}; z[2 * d + 1][tt] = (f32x4){gbi, gbi, gbi, gbi}; }
#pragma unroll
                for (int ks = 0; ks < 4; ++ks) {
                    bf16x8 Wf[2];
#pragma unroll
                    for (int g2 = 0; g2 < 2; ++g2) Wf[g2] = d ? Af1[g2][ks] : *(const LAS bf16x8*)(lds + EM_GW0 + (g2 * 128 + 16 * w + c) * 272 + (32 * ks + 8 * q) * 2);
#pragma unroll
                    for (int tt = 0; tt < 4; ++tt) { const bf16x8 At = *(const LAS bf16x8*)(UB + (16 * tt + c) * 136 + 32 * ks + 8 * q);
#pragma unroll
                        for (int g2 = 0; g2 < 2; ++g2) z[2 * d + g2][tt] = __builtin_amdgcn_mfma_f32_16x16x32_bf16(At, Wf[g2], z[2 * d + g2][tt], 0, 0, 0); } }
                if (d == 0) {
                    int aoff2 = aoff; asm volatile("" : "+v"(aoff2) : "v"(z[0][3][3]), "v"(z[1][3][3]));
#pragma unroll
                    for (int g2 = 0; g2 < 2; ++g2)
#pragma unroll
                        for (int ks = 0; ks < 4; ++ks) Af1[g2][ks] = *(const bf16x8*)(gwt + (size_t)((2 + g2) * 8) * 16384 + aoff2 + 32 * ks);
                }
#pragma unroll
                for (int tt = 0; tt < 4; ++tt)
#pragma unroll
                    for (int r = 0; r < 4; ++r) {
                        const float uu = __uint_as_float((unsigned)UB[(16 * tt + 4 * q + r) * 136 + chl] << 16);
                        const float rg = __builtin_amdgcn_rcpf(1.f + __builtin_amdgcn_exp2f(z[2 * d][tt][r])), ig = __builtin_amdgcn_rcpf(1.f + __builtin_amdgcn_exp2f(z[2 * d + 1][tt][r]));
                        const float av = __builtin_amdgcn_exp2f(sp * rg);
                        z[2 * d][tt][r] = av; z[2 * d + 1][tt][r] = __builtin_amdgcn_sqrtf(fmaxf(1.f - av * av, 0.f)) * ig * uu;
                    }
            }
            if (PASS == 0) { if (mb < T) bb_compute(Bq, wsc, mix, mb, chb); mb += mstride; bb_load(Bq, proj, mb < T ? mb : T - 1, chb); }
            const int ch = head * 128 + chl;
            if (PASS == 0) {
                float A = 1.f, H = 0.f;
#pragma unroll
                for (int tt = 0; tt < 4; ++tt)
#pragma unroll
                    for (int r = 0; r < 4; ++r) { H = z[0][tt][r] * H + z[1][tt][r]; A *= z[0][tt][r]; }
                const float A1 = __shfl(A, c + 16), A2 = __shfl(A, c + 32), A3 = __shfl(A, c + 48), A0 = __shfl(A, c);
                const float H0 = __shfl(H, c), H1 = __shfl(H, c + 16), H2 = __shfl(H, c + 32), H3 = __shfl(H, c + 48);
                const float PF = (A0 * A1) * (A2 * A3), HF = ((H0 * A1 + H1) * A2 + H2) * A3 + H3;
                A = 1.f; H = 0.f;
#pragma unroll
                for (int tt = 3; tt >= 0; --tt)
#pragma unroll
                    for (int r = 3; r >= 0; --r) { H = z[2][tt][r] * H + z[3][tt][r]; A *= z[2][tt][r]; }
                const float B0 = __shfl(A, c), B1 = __shfl(A, c + 16), B2 = __shfl(A, c + 32), B3 = __shfl(A, c + 48);
                const float G0 = __shfl(H, c), G1 = __shfl(H, c + 16), G2 = __shfl(H, c + 32), G3 = __shfl(H, c + 48);
                const float PB = (B0 * B1) * (B2 * B3), HB = ((G3 * B2 + G2) * B1 + G1) * B0 + G0;
                if (q == 0) { sumF[((size_t)(b * NCH + n)) * 1024 + ch] = (f32x2){PF, HF}; sumB[((size_t)(b * NCH + n)) * 1024 + ch] = (f32x2){PB, HB}; }
            } else {
                const float cfv = CF[ci * 128 + chl], cbv = CB[ci * 128 + chl];
                {
                    float A = 1.f, H = 0.f;
#pragma unroll
                    for (int tt = 0; tt < 4; ++tt)
#pragma unroll
                        for (int r = 0; r < 4; ++r) { H = z[0][tt][r] * H + z[1][tt][r]; A *= z[0][tt][r]; z[1][tt][r] = H; z[0][tt][r] = A; }
                    const float A0 = __shfl(A, c), A1 = __shfl(A, c + 16), A2 = __shfl(A, c + 32);
                    const float H0 = __shfl(H, c), H1 = __shfl(H, c + 16), H2 = __shfl(H, c + 32);
                    const float c1 = A0 * cfv + H0, c2 = A1 * c1 + H1, c3 = A2 * c2 + H2;
                    const float cin = q == 0 ? cfv : (q == 1 ? c1 : (q == 2 ? c2 : c3));
#pragma unroll
                    for (int tt = 0; tt < 4; ++tt)
#pragma unroll
                        for (int r = 0; r < 4; ++r) z[1][tt][r] = z[0][tt][r] * cin + z[1][tt][r];
                }
                {
                    float A = 1.f, H = 0.f;
#pragma unroll
                    for (int tt = 3; tt >= 0; --tt)
#pragma unroll
                        for (int r = 3; r >= 0; --r) { H = z[2][tt][r] * H + z[3][tt][r]; A *= z[2][tt][r]; z[3][tt][r] = H; z[2][tt][r] = A; }
                    const float A1 = __shfl(A, c + 16), A2 = __shfl(A, c + 32), A3 = __shfl(A, c + 48);
                    const float H1 = __shfl(H, c + 16), H2 = __shfl(H, c + 32), H3 = __shfl(H, c + 48);
                    const float d2 = A3 * cbv + H3, d1 = A2 * d2 + H2, d0 = A1 * d1 + H1;
                    const float cin = q == 3 ? cbv : (q == 2 ? d2 : (q == 1 ? d1 : d0));
#pragma unroll
                    for (int tt = 0; tt < 4; ++tt)
#pragma unroll
                        for (int r = 0; r < 4; ++r) z[1][tt][r] += z[2][tt][r] * cin + z[3][tt][r];
                }
#pragma unroll
                for (int tt = 0; tt < 4; ++tt)
#pragma unroll
                    for (int r = 0; r < 4; ++r) { const size_t tok = tok0 + 16 * q + 4 * tt + r;
                        const float o = z[1][tt][r] * __uint_as_float((unsigned)zav[tt][r] << 16);
                        *(unsigned short*)(mix + tok * 2048 + ch) = (unsigned short)(pk2(o, 0.f) & 0xffffu); }
            }
            if (PASS == 0) { if (mb < T) bb_compute(Bq, wsc, mix, mb, chb); mb += mstride; }
            R = Rn;
            RAW_BAR();
        }
    }
    if (PASS == 0) {
        for (; mb < T; mb += mstride) { BbRaw Bq; bb_load(Bq, proj, mb, chb); bb_compute(Bq, wsc, mix, mb, chb); }
    }
}

__device__ __forceinline__ void p5_rows(LAS unsigned char* lds, const Args& a, int G) {
    const int tid = threadIdx.x, lane = tid & 63, w = __builtin_amdgcn_readfirstlane(tid >> 6), q = lane >> 4, c = lane & 15;
    const bf16* Y = (const bf16*)(a.ws + WS_Y); bf16* H1 = (bf16*)(a.ws + WS_H1); bf16* LR = (bf16*)(a.ws + WS_LR);
    const bf16* WlrT = (const bf16*)(a.ws + WS_W3) + (size_t)3072 * D;
    LAS bf16* HL = (LAS bf16*)lds;
    LAS float* PL = (LAS float*)(lds + 66560);
    f32x4 g1[4], g2[4]; row_load(a.e_npost, lane, g1); row_load(a.o_npre, lane, g2);
    bf16x8 Bf[2][4];
#pragma unroll
    for (int nt = 0; nt < 2; ++nt)
#pragma unroll
        for (int ks = 0; ks < 4; ++ks) Bf[nt][ks] = *(const bf16x8*)(WlrT + (size_t)(16 * nt + c) * D + 128 * w + 32 * ks + 8 * q);
    for (int rg = blockIdx.x; rg < T / 32; rg += G) {
#pragma unroll
        for (int i = 0; i < 4; ++i) { const int rl = 4 * w + i; const size_t m = (size_t)rg * 32 + rl;
            f32x4 y[4], xv[4]; row_load_bf16(Y + m * D, lane, y); row_load(a.x + m * D, lane, xv);
            const float rs = rsqrtf(row_sumsq(y) * (1.f / D) + EPS);
#pragma unroll
            for (int j = 0; j < 4; ++j) xv[j] = xv[j] + y[j] * rs * g1[j];
            row_store_bf16((bf16*)(a.ws + WS_Y) + m * D, lane, xv);
            const float rs2 = rsqrtf(row_sumsq(xv) * (1.f / D) + EPS);
            u32x2* o = (u32x2*)(H1 + m * D) + lane;
#pragma unroll
            for (int j = 0; j < 4; ++j) { const f32x4 hv = xv[j] * rs2 * g2[j]; u32x2 pw; pw.x = pk2(hv.x, hv.y); pw.y = pk2(hv.z, hv.w);
                o[64 * j] = pw; *(LAS u32x2*)(HL + rl * 1032 + 4 * lane + 256 * j) = pw; }
        }
        RAW_BAR();
        f32x4 d[2][2];
#pragma unroll
        for (int mt = 0; mt < 2; ++mt) { d[mt][0] = (f32x4){0.f, 0.f, 0.f, 0.f}; d[mt][1] = (f32x4){0.f, 0.f, 0.f, 0.f}; }
#pragma unroll
        for (int ks = 0; ks < 4; ++ks)
#pragma unroll
            for (int mt = 0; mt < 2; ++mt) { const bf16x8 Af = *(const LAS bf16x8*)(HL + (16 * mt + c) * 1032 + 128 * w + 32 * ks + 8 * q);
                d[mt][0] = __builtin_amdgcn_mfma_f32_16x16x32_bf16(Af, Bf[0][ks], d[mt][0], 0, 0, 0); d[mt][1] = __builtin_amdgcn_mfma_f32_16x16x32_bf16(Af, Bf[1][ks], d[mt][1], 0, 0, 0); }
#pragma unroll
        for (int mt = 0; mt < 2; ++mt)
#pragma unroll
            for (int r = 0; r < 4; ++r) { PL[(w * 32 + 16 * mt + 4 * q + r) * 32 + c] = d[mt][0][r]; PL[(w * 32 + 16 * mt + 4 * q + r) * 32 + 16 + c] = d[mt][1][r]; }
        RAW_BAR();
#pragma unroll
        for (int i = 0; i < 2; ++i) { const int row = (tid >> 5) + 16 * i, n = tid & 31; float sacc = 0.f;
#pragma unroll
          for (int ww = 0; ww < 8; ++ww) sacc += PL[(ww * 32 + row) * 32 + n];
          LR[((size_t)rg * 32 + row) * 32 + n] = (bf16)(pk2(sacc, 0.f) & 0xffffu); }
    }
}
__device__ __forceinline__ void p8_rows(const Args& a, int G) {
    const int tid = threadIdx.x, lane = tid & 63, wave = tid >> 6, gw = blockIdx.x * NWAVES + wave, NGW = G * NWAVES;
    const bf16* proj = (const bf16*)(a.ws + WS_PROJ);
    bf16* M1 = (bf16*)(a.ws + WS_M1);
    const f32x4 gn = *((const f32x4*)a.g_ng + lane);
    for (int m = gw; m < T; m += NGW) {
        f32x4 of[4], ob[4], rr[4]; row_load_bf16(proj + (size_t)m * ODD_PAD, lane, of); row_load_bf16((const bf16*)(a.ws + WS_OB2) + (size_t)m * D, lane, ob);
        row_load_bf16(proj + (size_t)m * ODD_PAD + 2048, lane, rr);
#pragma unroll
        for (int j = 0; j < 4; ++j) { f32x4 o = of[j] + ob[j];
            const float ss = wave_sum((o.x * o.x + o.y * o.y) + (o.z * o.z + o.w * o.w));
            const float rs = rsqrtf(ss * (1.f / 256.f) + EPS);
            o = o * rs * gn;
            of[j] = (f32x4){o.x * siluf_(rr[j].x), o.y * siluf_(rr[j].y), o.z * siluf_(rr[j].z), o.w * siluf_(rr[j].w)}; }
        row_store_bf16(M1 + (size_t)m * D, lane, of);
    }
}
__device__ __forceinline__ void p10_rows(const Args& a, int G) {
    const int tid = threadIdx.x, lane = tid & 63, wave = tid >> 6, gw = blockIdx.x * NWAVES + wave, NGW = G * NWAVES;
    const bf16* X1 = (const bf16*)(a.ws + WS_Y); const bf16* Y2 = (const bf16*)(a.ws + WS_Y2);
    f32x4 g2[4]; row_load(a.o_npost, lane, g2);
    for (int m = gw; m < T; m += NGW) {
        f32x4 y2[4], xv[4]; row_load_bf16(X1 + (size_t)m * D, lane, xv); row_load_bf16(Y2 + (size_t)m * D, lane, y2);
        const float rs2 = rsqrtf(row_sumsq(y2) * (1.f / D) + EPS);
        f32x4* o = (f32x4*)(a.out + (size_t)m * D) + lane;
#pragma unroll
        for (int j = 0; j < 4; ++j) o[64 * j] = xv[j] + y2[j] * rs2 * g2[j];
    }
}

constexpr int GL_QI = 0, GL_KI = 17408, GL_DEC = 34816, GL_IMG = 35840, GL_VT = 35840, GL_BUF = 44032;
constexpr int GL_NI1 = GL_IMG / 1024, GL_NIV = 8;
typedef short v4i16_t __attribute__((ext_vector_type(4)));
__device__ __forceinline__ bf16x8 ld_tr8(const LAS unsigned char* img, int RS, int r0, int c0, int lane) {
    const int g = lane >> 4, qq = (lane & 15) >> 2, pp = lane & 3;
    const LAS unsigned char* p0 = img + (r0 + 8 * g + qq) * RS + 2 * c0 + 8 * pp;
    const v4i16_t lo = __builtin_amdgcn_ds_read_tr16_b64_v4i16((LAS v4i16_t*)p0), hi = __builtin_amdgcn_ds_read_tr16_b64_v4i16((LAS v4i16_t*)(p0 + 4 * RS));
    return __builtin_shufflevector(lo, hi, 0, 1, 2, 3, 4, 5, 6, 7);
}
__device__ __forceinline__ bf16x8 ld_tr8g(const LAS unsigned char* img, int RS, int rlo, int rhi, int c0, int lane) {
    const int qq = (lane & 15) >> 2, pp = lane & 3;
    const v4i16_t lo = __builtin_amdgcn_ds_read_tr16_b64_v4i16((LAS v4i16_t*)(img + (rlo + qq) * RS + 2 * c0 + 8 * pp)), hi = __builtin_amdgcn_ds_read_tr16_b64_v4i16((LAS v4i16_t*)(img + (rhi + qq) * RS + 2 * c0 + 8 * pp));
    return __builtin_shufflevector(lo, hi, 0, 1, 2, 3, 4, 5, 6, 7);
}
__device__ __forceinline__ bf16x8 pack8(const f32x4& lo, const f32x4& hi) {
    u32x4 p; p.x = pk2(lo[0], lo[1]); p.y = pk2(lo[2], lo[3]); p.z = pk2(hi[0], hi[1]); p.w = pk2(hi[2], hi[3]);
    return __builtin_bit_cast(bf16x8, p);
}
__device__ __forceinline__ bf16x8 ld2x8(const LAS bf16* p0, const LAS bf16* p1) {
    const u32x2 a = *(const LAS u32x2*)p0, b = *(const LAS u32x2*)p1; u32x4 r; r.x = a.x; r.y = a.y; r.z = b.x; r.w = b.y; return __builtin_bit_cast(bf16x8, r);
}
struct GlaRaw { bf16x8 Bz[2][4]; u32x2 qv[4], kv[4]; };
__device__ __forceinline__ void gla_load(GlaRaw& R, const bf16* proj, const bf16* lrp, int b, int h, int n, int w, int q, int c) {
    const size_t tok0 = (size_t)b * SEQ + (size_t)n * CH;
    const int kk0 = 16 * w + 4 * q;
#pragma unroll
    for (int tt = 0; tt < 4; ++tt) {
        const bf16* row = proj + (tok0 + 16 * tt + c) * ODD_PAD;
        const bf16* lr = lrp + (tok0 + 16 * tt + c) * 32 + 8 * (q & 1);
        R.Bz[0][tt] = *(const bf16x8*)lr; R.Bz[1][tt] = *(const bf16x8*)(lr + 16);
        R.qv[tt] = *(const u32x2*)(row + h * 128 + kk0); R.kv[tt] = *(const u32x2*)(row + 512 + h * 128 + kk0);
    }
}
__device__ __forceinline__ unsigned char* gla_img1(const Args& a, int b, int h, int dir, int n) {
    unsigned char* base = dir ? (a.ws + WS_IMG1B) : (unsigned char*)a.out;
    return base + ((size_t)((b * 4 + h) * NCH + n)) * GL_IMG;
}

__device__ __forceinline__ void gla_stage2(unsigned char* img0, unsigned char* img1, const GlaRaw& R, const bf16x8 (&Az)[2], const f32x4 (&bz)[2], int w, int q, int c) {
    const int kk0 = 16 * w + 4 * q;
    f32x4 g[2][4];
#pragma unroll
    for (int d = 0; d < 2; ++d)
#pragma unroll
        for (int tt = 0; tt < 4; ++tt) {
            const bf16x8 Bz = (q < 2) ? R.Bz[d][tt] : (bf16x8){0, 0, 0, 0, 0, 0, 0, 0};
            const f32x4 zz = __builtin_amdgcn_mfma_f32_16x16x32_bf16(Az[d], Bz, (f32x4){0.f, 0.f, 0.f, 0.f}, 0, 0, 0);
#pragma unroll
            for (int r = 0; r < 4; ++r) { const float xx = zz[r] + bz[d][r];
                g[d][tt][r] = (fminf(xx, 0.f) * 1.4426950408889634f - __builtin_amdgcn_logf(1.f + __builtin_amdgcn_exp2f(-1.4426950408889634f * fabsf(xx)))) * (1.f / 16.f); }
        }
    f32x4 P[2][4], rt[2][4];
#pragma unroll
    for (int d = 0; d < 2; ++d)
#pragma unroll
        for (int tt = 0; tt < 4; ++tt)
#pragma unroll
            for (int r = 0; r < 4; ++r) { float v = g[d][tt][r];
                v += dpp_f<0x111>(0.f, v); v += dpp_f<0x112>(0.f, v); v += dpp_f<0x114>(0.f, v); v += dpp_f<0x118>(0.f, v);
                P[d][tt][r] = v; }
#pragma unroll
    for (int d = 0; d < 2; ++d)
#pragma unroll
        for (int tt = 0; tt < 4; ++tt)
#pragma unroll
            for (int r = 0; r < 4; ++r) rt[d][tt][r] = __shfl(P[d][tt][r], 15, 16);
    f32x4 tot[2];
#pragma unroll
    for (int d = 0; d < 2; ++d) { f32x4 run = (f32x4){0.f, 0.f, 0.f, 0.f};
#pragma unroll
        for (int tt = 0; tt < 4; ++tt) { P[d][tt] = P[d][tt] + run; run = run + rt[d][tt]; }
        tot[d] = run; }
#pragma unroll
    for (int tt = 0; tt < 4; ++tt) { const int t = 16 * tt + c;
        const u32x2 qv = R.qv[tt], kv = R.kv[tt];
        const float qf[4] = {bflo(qv.x), bfhi(qv.x), bflo(qv.y), bfhi(qv.y)}, kf[4] = {bflo(kv.x), bfhi(kv.x), bflo(kv.y), bfhi(kv.y)};
#pragma unroll
        for (int d = 0; d < 2; ++d) { unsigned char* buf = d ? img1 : img0;
            float qi[4], ki[4];
#pragma unroll
            for (int r = 0; r < 4; ++r) { const float bc = d ? (tot[1][r] - P[1][tt][r] + g[1][tt][r]) : P[0][tt][r];
                qi[r] = qf[r] * 0.08838834764831845f * __builtin_amdgcn_exp2f(bc); ki[r] = kf[r] * __builtin_amdgcn_exp2f(-bc); }
            u32x2 o; o.x = pk2(qi[0], qi[1]); o.y = pk2(qi[2], qi[3]); *(u32x2*)((bf16*)(buf + GL_QI) + t * 136 + kk0) = o;
            o.x = pk2(ki[0], ki[1]); o.y = pk2(ki[2], ki[3]); *(u32x2*)((bf16*)(buf + GL_KI) + t * 136 + kk0) = o; }
    }
    if (c == 0) {
#pragma unroll
        for (int d = 0; d < 2; ++d) *(f32x4*)((float*)((d ? img1 : img0) + GL_DEC) + kk0) = (f32x4){__builtin_amdgcn_exp2f(tot[d][0]), __builtin_amdgcn_exp2f(tot[d][1]), __builtin_amdgcn_exp2f(tot[d][2]), __builtin_amdgcn_exp2f(tot[d][3])};
    }
}
__device__ __forceinline__ void gla_prep(LAS unsigned char* lds, const Args& a, int G) {
    const int tid = threadIdx.x, lane = tid & 63, w = __builtin_amdgcn_readfirstlane(tid >> 6), q = lane >> 4, c = lane & 15;
    const bf16* proj = (const bf16*)(a.ws + WS_PROJ);
    const bf16* lrp = (const bf16*)(a.ws + WS_LR);
    constexpr int NU = NB * 4 * NCH;
    int u = blockIdx.x;
    if (u >= NU) return;
    GlaRaw R, Rn;
    bf16x8 Az[2]; f32x4 bz[2];
#define GLA_GATE_W(AZ, BZ, h_) do { _Pragma("unroll") for (int d_ = 0; d_ < 2; ++d_) { float wv[8]; \
        _Pragma("unroll") for (int jj = 0; jj < 8; ++jj) wv[jj] = (q < 2) ? a.g_wlr[(size_t)(d_ * 16 + 8 * q + jj) * 512 + (h_) * 128 + 16 * w + c] : 0.f; \
        u32x4 p_; p_.x = pk2(wv[0], wv[1]); p_.y = pk2(wv[2], wv[3]); p_.z = pk2(wv[4], wv[5]); p_.w = pk2(wv[6], wv[7]); AZ[d_] = __builtin_bit_cast(bf16x8, p_); \
        BZ[d_] = *(const f32x4*)(a.g_bg + d_ * 512 + (h_) * 128 + 16 * w + 4 * q); } } while (0)
    int hcur;
    { const int n = u & (NCH - 1), h = (u >> 6) & 3, b = u >> 8; gla_load(R, proj, lrp, b, h, n, w, q, c); GLA_GATE_W(Az, bz, h); hcur = h; }
    for (; u < NU; u += G) {
        const int n = u & (NCH - 1), h = (u >> 6) & 3, b = u >> 8;
        if (h != hcur) { GLA_GATE_W(Az, bz, h); hcur = h; }
        { const int u2 = (u + G < NU) ? u + G : u; const int n2 = u2 & (NCH - 1), h2 = (u2 >> 6) & 3, b2 = u2 >> 8; gla_load(Rn, proj, lrp, b2, h2, n2, w, q, c); }
        gla_stage2(gla_img1(a, b, h, 0, n), gla_img1(a, b, h, 1, n), R, Az, bz, w, q, c);
        R = Rn;
    }
#undef GLA_GATE_W
}

__device__ __forceinline__ void gla_dma(LAS unsigned char* buf, const unsigned char* img1, const bf16* vsrc, int w, int lane) {
#pragma unroll
    for (int r = 0; r < (GL_NI1 + GL_NIV + 7) / 8; ++r) { const int k = w + 8 * r;
        if (k < GL_NI1) __builtin_amdgcn_global_load_lds((const unsigned*)(img1 + k * 1024 + lane * 16), (LAS unsigned*)(buf + k * 1024), 16, 0, 0);
        else if (k < GL_NI1 + GL_NIV) __builtin_amdgcn_global_load_lds((const unsigned*)(vsrc + (size_t)(8 * (k - GL_NI1) + (lane >> 3)) * ODD_PAD + (lane & 7) * 8), (LAS unsigned*)(buf + GL_VT + (k - GL_NI1) * 1024), 16, 0, 0); }
}
__device__ __forceinline__ void gla_phase(LAS unsigned char* lds, const Args& a, int G) {
    const int tid = threadIdx.x, lane = tid & 63, w = __builtin_amdgcn_readfirstlane(tid >> 6), q = lane >> 4, c = lane & 15;
    bf16* proj = (bf16*)(a.ws + WS_PROJ);
    const int I = w >> 1, E0 = 2 * (w & 1);
    for (int blk = blockIdx.x; blk < 256; blk += G) {
        const int xcd = blk & 7, idx = blk >> 3, sl = idx & 3, grp = xcd * 8 + (idx >> 2), dir = grp & 1, h = (grp >> 1) & 3, b = grp >> 3;
        bf16* O = (dir ? (bf16*)(a.ws + WS_OB2) : proj) + h * 256 + sl * 64;
        const int ostride = dir ? D : ODD_PAD;
        const bf16* vcol = proj + 1024 + h * 256 + sl * 64;
        f32x4 S[8][2];
#pragma unroll
        for (int dt = 0; dt < 8; ++dt) { S[dt][0] = (f32x4){0.f, 0.f, 0.f, 0.f}; S[dt][1] = (f32x4){0.f, 0.f, 0.f, 0.f}; }
        __syncthreads();
        { const int n = dir ? NCH - 1 : 0; gla_dma(lds, gla_img1(a, b, h, dir, n), vcol + ((size_t)b * SEQ + (size_t)n * CH) * ODD_PAD, w, lane); }
        asm volatile("s_waitcnt vmcnt(0)" ::: "memory"); RAW_BAR();
        for (int s = 0; s < NCH; ++s) {
            const int n = dir ? NCH - 1 - s : s;
            if (s + 1 < NCH) { const int n1 = dir ? n - 1 : n + 1; gla_dma(lds + ((s + 1) & 1) * GL_BUF, gla_img1(a, b, h, dir, n1), vcol + ((size_t)b * SEQ + (size_t)n1 * CH) * ODD_PAD, w, lane); }
            LAS unsigned char* buf = lds + (s & 1) * GL_BUF;
            const LAS bf16* QI = (const LAS bf16*)(buf + GL_QI); const LAS bf16* KI = (const LAS bf16*)(buf + GL_KI);
            const LAS unsigned char* VI = buf + GL_VT; const LAS float* DEC = (const LAS float*)(buf + GL_DEC);
            f32x4 sc[4];
#pragma unroll
            for (int jt = 0; jt < 4; ++jt) sc[jt] = (f32x4){0.f, 0.f, 0.f, 0.f};
#pragma unroll
            for (int ks = 0; ks < 4; ++ks) { const bf16x8 Bq = *(const LAS bf16x8*)(QI + (16 * I + c) * 136 + 32 * ks + 8 * q);
#pragma unroll
                for (int jt = 0; jt < 4; ++jt) { const bool live = dir ? (jt >= I) : (jt <= I);
                    if (live) { const bf16x8 Ak = *(const LAS bf16x8*)(KI + (16 * jt + c) * 136 + 32 * ks + 8 * q); sc[jt] = __builtin_amdgcn_mfma_f32_16x16x32_bf16(Ak, Bq, sc[jt], 0, 0, 0); } } }
#pragma unroll
            for (int jt = 0; jt < 4; ++jt) if (jt == I) {
#pragma unroll
                for (int r = 0; r < 4; ++r) { const bool keep = dir ? (4 * q + r >= c) : (4 * q + r <= c); if (!keep) sc[jt][r] = 0.f; } }
            const bf16x8 Bs0 = pack8(sc[0], sc[1]), Bs1 = pack8(sc[2], sc[3]);
#pragma unroll
            for (int e = 0; e < 2; ++e) { const int E = E0 + e;
                f32x4 oa = (f32x4){0.f, 0.f, 0.f, 0.f};
                oa = __builtin_amdgcn_mfma_f32_16x16x32_bf16(ld_tr8g(VI, 128, 4 * q, 16 + 4 * q, 16 * E, lane), Bs0, oa, 0, 0, 0);
                oa = __builtin_amdgcn_mfma_f32_16x16x32_bf16(ld_tr8g(VI, 128, 32 + 4 * q, 48 + 4 * q, 16 * E, lane), Bs1, oa, 0, 0, 0);
                const LAS bf16* qrow = QI + (16 * I + c) * 136;
#pragma unroll
                for (int ks = 0; ks < 4; ++ks) oa = __builtin_amdgcn_mfma_f32_16x16x32_bf16(pack8(S[2 * ks][e], S[2 * ks + 1][e]), ld2x8(qrow + 32 * ks + 4 * q, qrow + 32 * ks + 16 + 4 * q), oa, 0, 0, 0);
                const size_t tok = (size_t)b * SEQ + (size_t)n * CH + 16 * I + c;
                u32x2 o; o.x = pk2(oa[0], oa[1]); o.y = pk2(oa[2], oa[3]);
                *(u32x2*)(O + tok * ostride + 16 * E + 4 * q) = o;
            }
#pragma unroll
            for (int cs = 0; cs < 2; ++cs) {
                const bf16x8 Bv0 = ld_tr8(VI, 128, 32 * cs, 16 * E0, lane), Bv1 = ld_tr8(VI, 128, 32 * cs, 16 * (E0 + 1), lane);
#pragma unroll
                for (int dt = 0; dt < 8; ++dt) { const bf16x8 Ak = ld_tr8(buf + GL_KI, 272, 32 * cs, 16 * dt, lane);
                    S[dt][0] = __builtin_amdgcn_mfma_f32_16x16x32_bf16(Ak, Bv0, S[dt][0], 0, 0, 0); S[dt][1] = __builtin_amdgcn_mfma_f32_16x16x32_bf16(Ak, Bv1, S[dt][1], 0, 0, 0); } }
#pragma unroll
            for (int dt = 0; dt < 8; ++dt) { const f32x4 dc = *(const LAS f32x4*)(DEC + 16 * dt + 4 * q); S[dt][0] = S[dt][0] * dc; S[dt][1] = S[dt][1] * dc; }
            asm volatile("s_waitcnt vmcnt(2)" ::: "memory");
            RAW_BAR();
        }
    }
}

#define XB_TMO      128
#define XB_XCNT(j)  (256  + 64 * (j))
#define XB_XSUB(j)  (1280 + 64 * (j))
#define XB_XGEN(j)  (2304 + 64 * (j))
#define XB_TOP      3328
#define XB_TOPGEN   3392
#define XCD_BAR_WORDS 3456
#define XB_SPIN_CAP (1u << 20)
__device__ __forceinline__ unsigned xb_ld(unsigned* p)              { return __hip_atomic_load(p, __ATOMIC_RELAXED, __HIP_MEMORY_SCOPE_AGENT); }
__device__ __forceinline__ unsigned xb_add(unsigned* p, unsigned v) { return __hip_atomic_fetch_add(p, v, __ATOMIC_RELAXED, __HIP_MEMORY_SCOPE_AGENT); }
__device__ __forceinline__ unsigned xb_xcc_id() { return (unsigned)__builtin_amdgcn_s_getreg((3 << 11) | 20) & 0xFu; }
#define XB_SPIN(cond, bar) do { unsigned _sp = 0; while (cond) { __builtin_amdgcn_s_sleep(1); \
    if ((++_sp & 255u) == 0u) { if (xb_ld(&(bar)[XB_TMO])) break; if (_sp > XB_SPIN_CAP) { atomicAdd(&(bar)[XB_TMO], 1u); break; } } } } while (0)
struct XcdBarrier { unsigned* bar; unsigned x; volatile LAS unsigned* st; };
__device__ __forceinline__ XcdBarrier xcd_barrier_post(unsigned* bar, volatile LAS unsigned* st) {
    XcdBarrier b; b.bar = bar; b.x = xb_xcc_id(); b.st = st;
    if (threadIdx.x == 0) (void)xb_add(&bar[XB_XCNT(b.x)], 1u);
    return b;
}
__device__ __forceinline__ void xcd_barrier_complete(unsigned* bar, unsigned x, unsigned& nloc, unsigned& nx) {
    const unsigned G = gridDim.x * gridDim.y * gridDim.z;
    unsigned sum, cnt, mine, sp = 0u;
    for (;;) {
        sum = 0u; cnt = 0u; mine = 0u;
#pragma unroll
        for (unsigned j = 0; j < 16; ++j) { const unsigned c = xb_ld(&bar[XB_XCNT(j)]); sum += c; cnt += (c > 0u) ? 1u : 0u; mine = (j == x) ? c : mine; }
        if (sum == G) break;
        __builtin_amdgcn_s_sleep(1);
        if ((++sp & 255u) == 0u) { if (xb_ld(&bar[XB_TMO])) break; if (sp > XB_SPIN_CAP) { atomicAdd(&bar[XB_TMO], 1u); break; } }
    }
    nloc = mine > 0u ? mine : 1u; nx = cnt > 0u ? cnt : 1u;
}
__device__ __forceinline__ void xcd_barrier(const XcdBarrier& b) {
    asm volatile("s_waitcnt vmcnt(0)" ::: "memory");
    __syncthreads();
    if (threadIdx.x == 0) {
        unsigned* bar = b.bar;
        __builtin_amdgcn_s_waitcnt(0);
        unsigned nloc = b.st[0], nx = b.st[1];
        if (nloc == 0u) { xcd_barrier_complete(bar, b.x, nloc, nx); b.st[0] = nloc; b.st[1] = nx; }
        const unsigned old = xb_add(&bar[XB_XSUB(b.x)], 1u);
        const unsigned gen = old / nloc;
        if (old + 1u == (gen + 1u) * nloc) {
            __builtin_amdgcn_fence(__ATOMIC_RELEASE, "agent");
            asm volatile("s_waitcnt vmcnt(0)" ::: "memory");
            const unsigned og = xb_add(&bar[XB_TOP], 1u);
            const unsigned tg = og / nx;
            if (og + 1u == (tg + 1u) * nx) xb_add(&bar[XB_TOPGEN], 1u);
            else XB_SPIN(xb_ld(&bar[XB_TOPGEN]) == tg, bar);
            __builtin_amdgcn_fence(__ATOMIC_ACQUIRE, "agent");
            xb_add(&bar[XB_XGEN(b.x)], 1u);
            asm volatile("s_waitcnt vmcnt(0)" ::: "memory");
        } else {
            XB_SPIN(xb_ld(&bar[XB_XGEN(b.x)]) == gen, bar);
            __builtin_amdgcn_fence(__ATOMIC_ACQUIRE, "agent");
            asm volatile("s_waitcnt vmcnt(0)" ::: "memory");
        }
    }
    __syncthreads();
}

__global__ void __launch_bounds__(NT, 2) mega(Args a) {
    extern __shared__ __attribute__((aligned(16))) unsigned char lds_raw[];
    LAS unsigned char* lds = (LAS unsigned char*)lds_raw;
    const int G = gridDim.x;
    cg::grid_group grid = cg::this_grid();
    const int lo = a.ph_lo, hi = a.ph_hi;
#ifndef PHMASK
#define PHMASK 0xfff
#endif
#define IN(k) (((PHMASK >> (k)) & 1) && lo <= (k) && (k) < hi)
#define SEAM(k) do { if (IN(k) && IN((k) + 1)) xcd_barrier(xbar); } while (0)
    volatile LAS unsigned* xst = (volatile LAS unsigned*)(lds + 131072 + 64);
    if (threadIdx.x < 2) xst[threadIdx.x] = 0u;
    __syncthreads();
    XcdBarrier xbar = xcd_barrier_post((unsigned*)(a.ws + WS_CTL), xst);
    if (lo < 0) grid.sync();
    if (IN(0)) p0_prologue(lds, a, G);
    SEAM(0);
    if (IN(1)) { pg8::Gemm g{(const bf16*)a.out, (const bf16*)(a.ws + WS_W1), T, EVEN_IN, D}; pg8::StaticOrder S; S.init(T, EVEN_IN, G, (int)blockIdx.x);
        pg8::EpiBf16 E{(bf16*)(a.ws + WS_PROJ), EVEN_IN, 4, 8, 20, 24};   pg8::gemm_phase<pg8::EpiBf16, pg8::StaticOrder, true, true>(lds, g, S, E); }
    SEAM(1);
#ifndef REPMASK
#define REPMASK 0
#endif
#define REP(k) ((REPMASK >> (k)) & 1)
    if (IN(2)) { even_mixer<0>(lds, a, G); if (REP(2)) even_mixer<0>(lds, a, G); }
    SEAM(2);
    if (IN(3)) { even_mixer<1>(lds, a, G); if (REP(3)) even_mixer<1>(lds, a, G); }
    SEAM(3);
    if (IN(4)) { pg8::Gemm g{(const bf16*)a.out, (const bf16*)(a.ws + WS_W2), T, D, 2048}; pg8::StaticOrder S; S.init(T, D, G, (int)blockIdx.x);
        pg8::EpiBf16 E{(bf16*)(a.ws + WS_Y), D, 0, 0, 0, 0}; pg8::gemm_phase<pg8::EpiBf16, pg8::StaticOrder, true, true>(lds, g, S, E); }
    SEAM(4);
    if (IN(5)) p5_rows(lds, a, G);
    SEAM(5);
    if (IN(6)) { pg8::Gemm g{(const bf16*)(a.ws + WS_H1), (const bf16*)(a.ws + WS_W3), T, 3072, D}; pg8::StaticOrder S; S.init(T, 3072, G, (int)blockIdx.x);
        pg8::EpiBf16 E{(bf16*)(a.ws + WS_PROJ), ODD_PAD, 0, 0, 0, 0}; pg8::gemm_phase<pg8::EpiBf16, pg8::StaticOrder, true, true>(lds, g, S, E); }
    SEAM(6);
    if (IN(7)) gla_prep(lds, a, G);
    SEAM(7);
    if (IN(8)) { gla_phase(lds, a, G); if (REP(8)) gla_phase(lds, a, G); }
    SEAM(8);
    if (IN(9)) p8_rows(a, G);
    SEAM(9);
    if (IN(10)) { pg8::Gemm g{(const bf16*)(a.ws + WS_M1), (const bf16*)(a.ws + WS_W4), T, D, D}; pg8::StaticOrder S; S.init(T, D, G, (int)blockIdx.x);
        pg8::EpiBf16 E{(bf16*)(a.ws + WS_Y2), D, 0, 0, 0, 0}; pg8::gemm_phase<pg8::EpiBf16, pg8::StaticOrder, true, true>(lds, g, S, E); }
    SEAM(10);
    if (IN(11)) p10_rows(a, G);
#undef IN
#undef SEAM
}

extern "C" void kernel_launch(void* const* d_in, const int* in_sizes, int n_in, void* d_out, int out_size, void* d_ws, size_t ws_size, hipStream_t stream) {
    static int grid = 0;
    if (grid == 0) {
        if (n_in != 18 || in_sizes[0] != T * D || out_size != T * D || ws_size < WS_END) { fprintf(stderr, "kernel_launch: unexpected shapes / workspace (n_in %d, ws %zu)\n", n_in, ws_size); grid = -1; return; }
        int dev = 0, cus = 0, per_cu = 0;
        hipGetDevice(&dev); hipDeviceGetAttribute(&cus, hipDeviceAttributeMultiprocessorCount, dev);
        hipFuncSetAttribute((const void*)mega, hipFuncAttributeMaxDynamicSharedMemorySize, LDS_BYTES);
        hipOccupancyMaxActiveBlocksPerMultiprocessor(&per_cu, (const void*)mega, NT, LDS_BYTES);
        if (per_cu < 1) { fprintf(stderr, "kernel_launch: occupancy query reports %d blocks per CU\n", per_cu); grid = -1; return; }
        grid = cus;
        if (grid > 256) grid = 256;
    }
    if (grid < 0) return;
    Args a{};
    a.x = (const float*)d_in[0]; a.e_npre = (const float*)d_in[1]; a.e_npost = (const float*)d_in[2]; a.e_win = (const float*)d_in[3]; a.rg_cw = (const float*)d_in[4];
    a.rg_cb = (const float*)d_in[5]; a.rg_gw = (const float*)d_in[6]; a.rg_gb = (const float*)d_in[7]; a.rg_lam = (const float*)d_in[8]; a.sc_w = (const float*)d_in[9];
    a.e_wout = (const float*)d_in[10]; a.o_npre = (const float*)d_in[11]; a.o_npost = (const float*)d_in[12]; a.o_win = (const float*)d_in[13]; a.g_wlr = (const float*)d_in[14];
    a.g_bg = (const float*)d_in[15]; a.g_ng = (const float*)d_in[16]; a.o_wout = (const float*)d_in[17]; a.out = (float*)d_out; a.ws = (unsigned char*)d_ws;
#if MK_MULTI
    for (int p = 0; p <= 11; ++p) { a.ph_lo = p; a.ph_hi = p + 1; hipLaunchKernelGGL(mega, dim3(grid), dim3(NT), LDS_BYTES, stream, a); }
#else
    a.ph_lo = 0; a.ph_hi = 12;
    if (hipMemsetAsync((char*)d_ws + WS_CTL, 0, 16384, stream) != hipSuccess) { fprintf(stderr, "kernel_launch: memset failed\n"); return; }
    void* args[] = {&a};
    hipError_t e = hipLaunchCooperativeKernel((const void*)mega, dim3(grid), dim3(NT), args, LDS_BYTES, stream);
    if (e != hipSuccess) fprintf(stderr, "cooperative launch failed: %s (grid %d)\n", hipGetErrorString(e), grid);
#endif
}
```
